# Optimizing an MI355X kernel written in HIP

```python
import math
import jax
import jax.numpy as jnp
from jax import lax
import numpy as np

D_MODEL = 2048
BATCH = 2
SEQ = 4096
DEPTH = 4
DEC_BATCH = 16
DEC_SEQ = 64
PAST_LEN = 1024

CHUNK = 64
N_MIXERS = 2
N_LRU = (DEPTH + 1) // 2
N_ATTN = DEPTH // 2
LRU_W = D_MODEL
LRU_HEADS = 8
LRU_BLK = LRU_W // LRU_HEADS
LRU_CONV = 4
LRU_C = 8.0
DIFF_HEADS = 8
DK = D_MODEL // 16
DV = 2 * DK
ATT_QK_W = DIFF_HEADS * 2 * DK
ATT_V_W = DIFF_HEADS * DV
Q_BLOCK = 128
SWEEP_MIN_KEYS = 2048
MEM_TOKENS = 256
MEM_HEADS = 4
MEM_HD = D_MODEL // 8
MEM_W = MEM_HEADS * MEM_HD
D_FF = 5632
FFN_CONV = 3
RMS_EPS = 1e-6

kernel_name = 'hybrid_rglru_diffattn_stream_step'


def rms_norm(x, g, eps=RMS_EPS):
    xf = x.astype(jnp.float32)
    xf = xf * lax.rsqrt(jnp.mean(xf * xf, axis=-1, keepdims=True) + eps)
    return (xf * g.astype(jnp.float32)).astype(x.dtype)


def causal_dwconv(x, buf, w, b):
    width = w.shape[0]
    T = x.shape[1]
    xp = jnp.concatenate([buf.astype(x.dtype), x], axis=1)
    y = b + xp[:, 0:T] * w[0]
    for j in range(1, width):
        y = y + xp[:, j:j + T] * w[j]
    return y, xp[:, T:]


def linear_scan(a, b, h0):
    b = b.at[:, 0].add(a[:, 0] * h0)
    def combine(left, right):
        a_l, b_l = left
        a_r, b_r = right
        return a_l * a_r, a_r * b_l + b_r
    _, hs = lax.associative_scan(combine, (a, b), axis=1)
    return hs


def rg_lru(x, h0, w_a, b_a, w_x, b_x, lam):
    B, T, C = x.shape
    xf = x.astype(jnp.float32)
    xb = xf.reshape(B, T, LRU_HEADS, LRU_BLK)
    r = jax.nn.sigmoid(jnp.einsum('bthi,hij->bthj', xb, w_a.astype(jnp.float32)).reshape(B, T, C) + b_a.astype(jnp.float32))
    ig = jax.nn.sigmoid(jnp.einsum('bthi,hij->bthj', xb, w_x.astype(jnp.float32)).reshape(B, T, C) + b_x.astype(jnp.float32))
    log_a = LRU_C * r * jax.nn.log_sigmoid(lam.astype(jnp.float32))
    a = jnp.exp(log_a)
    gated = jnp.sqrt(-jnp.expm1(2.0 * log_a)) * (ig * xf)
    hs = linear_scan(a, gated, h0.astype(jnp.float32))
    return hs.astype(x.dtype), hs[:, -1].astype(x.dtype)


def diff_attention(q, k, v, q_pos, k_pos, lam):
    B, Tq = q.shape[0], q.shape[1]
    kf = k.astype(jnp.float32)
    vf = v.astype(jnp.float32)
    k_chunk = k_pos // CHUNK
    def attend(qb, qp):
        s = jnp.einsum('bqhcd,bkhcd->bhcqk', qb.astype(jnp.float32), kf) * (DK ** -0.5)
        visible = k_chunk[None, :] <= (qp // CHUNK)[:, None]
        s = jnp.where(visible, s, -jnp.inf)
        pr = jax.nn.softmax(s, axis=-1)
        wgt = pr[:, :, 0] - lam * pr[:, :, 1]
        return jnp.einsum('bhqk,bkhd->bqhd', wgt, vf)
    if k.shape[1] >= SWEEP_MIN_KEYS and Tq > Q_BLOCK and Tq % Q_BLOCK == 0:
        nb = Tq // Q_BLOCK
        qb = q.reshape(B, nb, Q_BLOCK, DIFF_HEADS, 2, DK).swapaxes(0, 1)
        pb = q_pos.reshape(nb, Q_BLOCK)
        o = lax.map(lambda args: attend(args[0], args[1]), (qb, pb))
        return o.swapaxes(0, 1).reshape(B, Tq, DIFF_HEADS, DV)
    return attend(q, q_pos)


def mem_attention(q, mk, mv):
    s = jnp.einsum('bthd,bmhd->bhtm', q.astype(jnp.float32), mk.astype(jnp.float32)) * (MEM_HD ** -0.5)
    pr = jax.nn.softmax(s, axis=-1)
    return jnp.einsum('bhtm,bmhd->bthd', pr, mv.astype(jnp.float32))


def mem_kv(mem, g_norm, w_kv, g_k):
    B, M, _ = mem.shape
    kv = rms_norm(mem, g_norm) @ w_kv
    k, v = jnp.split(kv, 2, axis=-1)
    k = rms_norm(k.reshape(B, M, MEM_HEADS, MEM_HD), g_k)
    return k, v.reshape(B, M, MEM_HEADS, MEM_HD)


def run_trunk(x, past_len, mem_k, mem_v, lru_h, lru_conv, attn_k_past, attn_v_past, ffn_conv, p):
    B, T, _ = x.shape
    q_pos = past_len + jnp.arange(T, dtype=jnp.int32)
    k_pos = jnp.arange(past_len + T, dtype=jnp.int32)
    new_h, new_lconv, new_k, new_v, new_fconv = [], [], [], [], []
    for i in range(DEPTH):
        j = i // N_MIXERS
        h = rms_norm(x, p['norm_mix'][i])
        if i % N_MIXERS == 0:
            z = h @ p['lru_w_in'][j]
            gate, xr, mq = jnp.split(z, [LRU_W, 2 * LRU_W], axis=-1)
            xc, buf = causal_dwconv(xr, lru_conv[j], p['lru_conv_w'][j], p['lru_conv_b'][j])
            hs, h_last = rg_lru(xc, lru_h[j], p['lru_gate_a_w'][j], p['lru_gate_a_b'][j],
                                p['lru_gate_x_w'][j], p['lru_gate_x_b'][j], p['lru_lambda'][j])
            mix = jax.nn.gelu(gate) * hs
            w_out = p['lru_w_out'][j]
            new_h.append(h_last)
            new_lconv.append(buf)
        else:
            z = h @ p['attn_w_in'][j]
            q, k, v, mq = jnp.split(z, [ATT_QK_W, 2 * ATT_QK_W, 2 * ATT_QK_W + ATT_V_W], axis=-1)
            q = rms_norm(q.reshape(B, T, DIFF_HEADS, 2, DK), p['attn_q_norm'][j])
            k = rms_norm(k.reshape(B, T, DIFF_HEADS, 2, DK), p['attn_k_norm'][j])
            v = v.reshape(B, T, DIFF_HEADS, DV)
            new_k.append(k)
            new_v.append(v)
            if attn_k_past is not None:
                k = jnp.concatenate([attn_k_past[j].astype(k.dtype), k], axis=1)
                v = jnp.concatenate([attn_v_past[j].astype(v.dtype), v], axis=1)
            lam_init = 0.8 - 0.6 * math.exp(-0.3 * i)
            lp = p['attn_lambda'][j].astype(jnp.float32)
            lam = jnp.exp(jnp.sum(lp[0] * lp[1])) - jnp.exp(jnp.sum(lp[2] * lp[3])) + lam_init
            o = diff_attention(q, k, v, q_pos, k_pos, lam)
            o = rms_norm(o, p['attn_subln'][j]) * (1.0 - lam_init)
            mix = o.reshape(B, T, ATT_V_W).astype(x.dtype)
            w_out = p['attn_w_out'][j]
        mq = rms_norm(mq.reshape(B, T, MEM_HEADS, MEM_HD), p['mem_q_norm'][i])
        mo = mem_attention(mq, mem_k[i], mem_v[i]).reshape(B, T, MEM_W).astype(x.dtype)
        x = x + jnp.concatenate([mix.astype(x.dtype), mo], axis=-1) @ w_out
        h = rms_norm(x, p['norm_ffn'][i])
        up, fbuf = causal_dwconv(h @ p['ffn_w_up'][i], ffn_conv[i], p['ffn_conv_w'][i], p['ffn_conv_b'][i])
        g, u = jnp.split(up, 2, axis=-1)
        x = x + (jax.nn.gelu(g) * u) @ p['ffn_w_down'][i]
        new_fconv.append(fbuf)
    return (x, jnp.stack(new_h), jnp.stack(new_lconv), jnp.stack(new_k), jnp.stack(new_v), jnp.stack(new_fconv))


def setup_inputs(seed: int = 0) -> dict:
    key = jax.random.key(seed)
    keys = iter(jax.random.split(key, 64))
    def normal(shape, scale=1.0):
        return scale * jax.random.normal(next(keys), shape, jnp.float32)
    def gain(shape):
        return 1.0 + 0.05 * jax.random.normal(next(keys), shape, jnp.float32)
    s_lam = jax.random.uniform(next(keys), (N_LRU, LRU_W), jnp.float32, 0.9, 0.999) ** (1.0 / LRU_C)
    lru_lambda = jnp.log(s_lam) - jnp.log1p(-s_lam)
    return {
        'x_prompt': normal((BATCH, SEQ, D_MODEL)),
        'x_sample': normal((DEC_BATCH, DEC_SEQ, D_MODEL)),
        'mem_prompt': normal((BATCH, MEM_TOKENS, D_MODEL)),
        'cache_attn_k': normal((N_ATTN, DEC_BATCH, PAST_LEN, DIFF_HEADS, 2, DK)),
        'cache_attn_v': normal((N_ATTN, DEC_BATCH, PAST_LEN, DIFF_HEADS, DV)),
        'cache_mem_k': normal((DEPTH, DEC_BATCH, MEM_TOKENS, MEM_HEADS, MEM_HD)),
        'cache_mem_v': normal((DEPTH, DEC_BATCH, MEM_TOKENS, MEM_HEADS, MEM_HD)),
        'state_lru_h': normal((N_LRU, DEC_BATCH, LRU_W), 0.5),
        'state_lru_conv': normal((N_LRU, DEC_BATCH, LRU_CONV - 1, LRU_W)),
        'state_ffn_conv': normal((DEPTH, DEC_BATCH, FFN_CONV - 1, 2 * D_FF)),
        'norm_mix': gain((DEPTH, D_MODEL)),
        'norm_ffn': gain((DEPTH, D_MODEL)),
        'lru_w_in': normal((N_LRU, D_MODEL, 2 * LRU_W + MEM_W), D_MODEL ** -0.5),
        'lru_conv_w': normal((N_LRU, LRU_CONV, LRU_W), LRU_CONV ** -0.5),
        'lru_conv_b': normal((N_LRU, LRU_W), 0.02),
        'lru_gate_a_w': normal((N_LRU, LRU_HEADS, LRU_BLK, LRU_BLK), LRU_BLK ** -0.5),
        'lru_gate_a_b': normal((N_LRU, LRU_W), 0.02),
        'lru_gate_x_w': normal((N_LRU, LRU_HEADS, LRU_BLK, LRU_BLK), LRU_BLK ** -0.5),
        'lru_gate_x_b': normal((N_LRU, LRU_W), 0.02),
        'lru_lambda': lru_lambda,
        'lru_w_out': normal((N_LRU, LRU_W + MEM_W, D_MODEL), (LRU_W + MEM_W) ** -0.5),
        'attn_w_in': normal((N_ATTN, D_MODEL, 2 * ATT_QK_W + ATT_V_W + MEM_W), D_MODEL ** -0.5),
        'attn_q_norm': gain((N_ATTN, DK)),
        'attn_k_norm': gain((N_ATTN, DK)),
        'attn_lambda': normal((N_ATTN, 4, DK), 0.1),
        'attn_subln': gain((N_ATTN, DV)),
        'attn_w_out': normal((N_ATTN, ATT_V_W + MEM_W, D_MODEL), (ATT_V_W + MEM_W) ** -0.5),
        'mem_norm': gain((DEPTH, D_MODEL)),
        'mem_w_kv': normal((DEPTH, D_MODEL, 2 * MEM_W), D_MODEL ** -0.5),
        'mem_q_norm': gain((DEPTH, MEM_HD)),
        'mem_k_norm': gain((DEPTH, MEM_HD)),
        'ffn_w_up': normal((DEPTH, D_MODEL, 2 * D_FF), D_MODEL ** -0.5),
        'ffn_conv_w': normal((DEPTH, FFN_CONV, 2 * D_FF), FFN_CONV ** -0.5),
        'ffn_conv_b': normal((DEPTH, 2 * D_FF), 0.02),
        'ffn_w_down': normal((DEPTH, D_FF, D_MODEL), D_FF ** -0.5),
    }


def reference(x_prompt, x_sample, mem_prompt, cache_attn_k, cache_attn_v, cache_mem_k, cache_mem_v,
              state_lru_h, state_lru_conv, state_ffn_conv,
              norm_mix, norm_ffn, lru_w_in, lru_conv_w, lru_conv_b, lru_gate_a_w, lru_gate_a_b,
              lru_gate_x_w, lru_gate_x_b, lru_lambda, lru_w_out, attn_w_in, attn_q_norm, attn_k_norm,
              attn_lambda, attn_subln, attn_w_out, mem_norm, mem_w_kv, mem_q_norm, mem_k_norm,
              ffn_w_up, ffn_conv_w, ffn_conv_b, ffn_w_down):
    p = {
        'norm_mix': norm_mix, 'norm_ffn': norm_ffn,
        'lru_w_in': lru_w_in, 'lru_conv_w': lru_conv_w, 'lru_conv_b': lru_conv_b,
        'lru_gate_a_w': lru_gate_a_w, 'lru_gate_a_b': lru_gate_a_b,
        'lru_gate_x_w': lru_gate_x_w, 'lru_gate_x_b': lru_gate_x_b,
        'lru_lambda': lru_lambda, 'lru_w_out': lru_w_out,
        'attn_w_in': attn_w_in, 'attn_q_norm': attn_q_norm, 'attn_k_norm': attn_k_norm,
        'attn_lambda': attn_lambda, 'attn_subln': attn_subln, 'attn_w_out': attn_w_out,
        'mem_q_norm': mem_q_norm,
        'ffn_w_up': ffn_w_up, 'ffn_conv_w': ffn_conv_w, 'ffn_conv_b': ffn_conv_b, 'ffn_w_down': ffn_w_down,
    }
    B = x_prompt.shape[0]
    dt = x_prompt.dtype
    mks, mvs = [], []
    for i in range(DEPTH):
        mk, mv = mem_kv(mem_prompt, mem_norm[i], mem_w_kv[i], mem_k_norm[i])
        mks.append(mk)
        mvs.append(mv)
    p_mem_k = jnp.stack(mks)
    p_mem_v = jnp.stack(mvs)
    zeros_h = jnp.zeros((N_LRU, B, LRU_W), dt)
    zeros_lconv = jnp.zeros((N_LRU, B, LRU_CONV - 1, LRU_W), dt)
    zeros_fconv = jnp.zeros((DEPTH, B, FFN_CONV - 1, 2 * D_FF), dt)
    y_prompt, p_lru_h, p_lru_conv, p_attn_k, p_attn_v, p_ffn_conv = run_trunk(
        x_prompt, 0, p_mem_k, p_mem_v, zeros_h, zeros_lconv, None, None, zeros_fconv, p)
    past_len = cache_attn_k.shape[2]
    y_sample, s_lru_h, s_lru_conv, s_attn_k, s_attn_v, s_ffn_conv = run_trunk(
        x_sample, past_len, cache_mem_k, cache_mem_v, state_lru_h, state_lru_conv,
        cache_attn_k, cache_attn_v, state_ffn_conv, p)
    return (y_prompt, y_sample, p_lru_h, p_lru_conv, p_attn_k, p_attn_v, p_mem_k, p_mem_v, p_ffn_conv,
            s_lru_h, s_lru_conv, s_attn_k, s_attn_v, s_ffn_conv)
```

```cpp
#include <hip/hip_runtime.h>
#include <stdio.h>
#include <stdint.h>

#ifndef MK_N_LAUNCHES
#define MK_N_LAUNCHES 0
#endif


constexpr int D = 2048, SEQ = 4096, NBP = 2, DSEQ = 64, NBS = 16, PAST = 1024;
constexpr int MP = NBP * SEQ, MS = NBS * DSEQ, M = MP + MS;
constexpr int N_IN_LRU = 5120, N_IN_ATT = 7168, K_OUT = 3072, N_UP = 11264, DFF = 5632, MEMW = 1024, MEMT = 256;
constexpr float EPS = 1e-6f;
constexpr float LOG2E = 1.4426950408889634f;
constexpr float QSCALE = 0.08838834764831845f * LOG2E;
constexpr float MQSCALE = 0.0625f * LOG2E;

enum { I_XP = 0, I_XS, I_MEM, I_CAK, I_CAV, I_CMK, I_CMV, I_SLH, I_SLC, I_SFC, I_NMIX, I_NFFN, I_LWIN, I_LCW, I_LCB, I_LGAW, I_LGAB, I_LGXW, I_LGXB,
       I_LLAM, I_LWOUT, I_AWIN, I_AQN, I_AKN, I_ALAM, I_ASUB, I_AWOUT, I_MNORM, I_MWKV, I_MQN, I_MKN, I_FUP, I_FCW, I_FCB, I_FDN, N_INPUTS };

constexpr size_t O_Y = 0;
constexpr size_t O_PLH = O_Y + (size_t)M * D;
constexpr size_t O_PLC = O_PLH + (size_t)2 * NBP * D;
constexpr size_t O_PAK = O_PLC + (size_t)2 * NBP * 3 * D;
constexpr size_t O_PAV = O_PAK + (size_t)2 * MP * D;
constexpr size_t O_PMK = O_PAV + (size_t)2 * MP * D;
constexpr size_t O_PMV = O_PMK + (size_t)4 * NBP * MEMT * MEMW;
constexpr size_t O_PFC = O_PMV + (size_t)4 * NBP * MEMT * MEMW;
constexpr size_t O_SLH = O_PFC + (size_t)4 * NBP * 2 * N_UP;
constexpr size_t O_SLC = O_SLH + (size_t)2 * NBS * D;
constexpr size_t O_SAK = O_SLC + (size_t)2 * NBS * 3 * D;
constexpr size_t O_SAV = O_SAK + (size_t)2 * MS * D;
constexpr size_t O_SFC = O_SAV + (size_t)2 * MS * D;
constexpr size_t O_END = O_SFC + (size_t)4 * NBS * 2 * N_UP;
static_assert(O_END == 100483072ull, "output size");

constexpr size_t MiB = 1ull << 20;
constexpr size_t WS_CTL = 0, CTL_BYTES = 64 * 1024;
constexpr size_t SZ_WINL = (size_t)N_IN_LRU * D * 2, SZ_WINA = (size_t)N_IN_ATT * D * 2, SZ_WOUT = (size_t)D * K_OUT * 2, SZ_WUP = (size_t)N_UP * D * 2, SZ_WDN = (size_t)D * DFF * 2;
constexpr size_t SZ_WKV = (size_t)4 * 2048 * D * 2, SZ_WG = (size_t)8 * 512 * 256 * 2;
constexpr size_t WS_WINL = 1 * MiB;
constexpr size_t WS_WINA = WS_WINL + 2 * SZ_WINL;
constexpr size_t WS_WOUT = WS_WINA + 2 * SZ_WINA;
constexpr size_t WS_WUP = WS_WOUT + 4 * SZ_WOUT;
constexpr size_t WS_WDN = WS_WUP + 4 * SZ_WUP;
constexpr size_t WS_WKV = WS_WDN + 4 * SZ_WDN;
constexpr size_t WS_WG = WS_WKV + SZ_WKV;
constexpr size_t WS_XB = WS_WG + 2 * SZ_WG;
constexpr size_t WS_MEMB = WS_XB + (size_t)M * D * 2;
constexpr size_t WS_SSA = WS_MEMB + (size_t)512 * D * 2;
constexpr size_t WS_SSB = WS_SSA + (size_t)M * 8 * 4;
constexpr size_t WS_MEMRS = WS_SSB + (size_t)M * 8 * 4;
constexpr size_t WS_CL8 = WS_MEMRS + 4096;
constexpr size_t WS_Z0 = WS_CL8 + (size_t)2 * 2048 * 4;
constexpr size_t WS_Z1 = WS_Z0 + (size_t)M * D * 2;
constexpr size_t WS_Z2 = WS_Z1 + (size_t)M * D * 2;
constexpr size_t WS_MQ = WS_Z2 + (size_t)M * D * 2;
constexpr size_t WS_HLOC = WS_MQ + (size_t)M * MEMW * 2;
constexpr size_t WS_PCUM = WS_HLOC + (size_t)M * D * 4;
constexpr size_t WS_AGGA = WS_PCUM + (size_t)M * D * 4;
constexpr size_t WS_AGGH = WS_AGGA + (size_t)144 * D * 4;
constexpr size_t WS_AOUT = WS_AGGH + (size_t)144 * D * 4;
constexpr size_t WS_UP = WS_AOUT + (size_t)M * K_OUT * 2;
constexpr size_t WS_ACT = WS_UP + (size_t)M * N_UP * 2;
constexpr size_t WS_MEMK = WS_ACT + (size_t)M * DFF * 2;
constexpr size_t WS_MEMV = WS_MEMK + (size_t)4 * 512 * MEMW * 2;
constexpr size_t WS_CAK = WS_MEMV + (size_t)4 * 512 * MEMW * 2;
constexpr size_t WS_CAV = WS_CAK + (size_t)2 * NBS * PAST * D * 2;
constexpr size_t WS_CMK = WS_CAV + (size_t)2 * NBS * PAST * D * 2;
constexpr size_t WS_CMV = WS_CMK + (size_t)4 * NBS * MEMT * MEMW * 2;
constexpr size_t WS_END = WS_CMV + (size_t)4 * NBS * MEMT * MEMW * 2;
static_assert(WS_WINA % 256 == 0 && WS_XB % 256 == 0 && WS_Z0 % 256 == 0 && WS_AOUT % 256 == 0 && WS_CAK % 256 == 0 && WS_END % 256 == 0, "ws alignment");

constexpr int CW_BAR = 4096;
constexpr int CW_QUEUE = 8192;

constexpr int LDS_EXCH = 131072;
constexpr int LDS_MISC = 131072 + 8192 + 1024;
constexpr int LDS_BYTES = LDS_MISC + 512;

#define GAS __attribute__((address_space(1)))
#define LAS __attribute__((address_space(3)))
typedef unsigned short bf16_t;
typedef short bf16x8 __attribute__((ext_vector_type(8)));
typedef short s16x4 __attribute__((ext_vector_type(4)));
typedef float f32x4 __attribute__((ext_vector_type(4)));
typedef float f32x2 __attribute__((ext_vector_type(2)));
typedef unsigned u32x4 __attribute__((ext_vector_type(4)));
typedef unsigned u32x2 __attribute__((ext_vector_type(2)));
#define LDS_WAIT() asm volatile("s_waitcnt lgkmcnt(0)" ::: "memory")
#define VM_WAIT() asm volatile("s_waitcnt vmcnt(0)" ::: "memory")

__device__ __forceinline__ unsigned f2bf(float f) { unsigned u = __builtin_bit_cast(unsigned, f); return (u + 0x7fffu + ((u >> 16) & 1u)) >> 16; }
__device__ __forceinline__ unsigned pk2(float lo, float hi) { return f2bf(lo) | (f2bf(hi) << 16); }
__device__ __forceinline__ float bf_lo(unsigned w) { return __builtin_bit_cast(float, w << 16); }
__device__ __forceinline__ float bf_hi(unsigned w) { return __builtin_bit_cast(float, w & 0xffff0000u); }
__device__ __forceinline__ float wave_sum(float v) {
#pragma unroll
    for (int o = 1; o < 64; o <<= 1) v += __shfl_xor(v, o);
    return v;
}
__device__ __forceinline__ float fexp2(float x) { return __builtin_amdgcn_exp2f(x); }
__device__ __forceinline__ float frcp(float x) { return __builtin_amdgcn_rcpf(x); }
__device__ __forceinline__ float sigmoidf_(float x) { return frcp(1.0f + fexp2(-x * LOG2E)); }
__device__ __forceinline__ float gelu_tanh(float x) { const float u = 0.7978845608028654f * (x + 0.044715f * x * x * x); return x * frcp(1.0f + fexp2(-2.0f * LOG2E * u)); }
namespace pg8 {
#define PG8_LAS __attribute__((address_space(3)))
typedef unsigned short bf16_t;
typedef short bf16x8 __attribute__((ext_vector_type(8)));
typedef float f32x4 __attribute__((ext_vector_type(4)));
typedef unsigned u32x4 __attribute__((ext_vector_type(4)));
constexpr int BM = 256, BK = 64, HALF = 128, HTB = HALF * BK * 2  , STAGE_BYTES = 8 * HTB, NXCD = 8, WGM = 8;

__host__ __device__ __forceinline__ int lds_byte(int r, int c) { const int st = (r >> 4) * 2 + (c >> 5), rr = r & 15, cc = c & 31, ob = rr * 64 + cc * 2; return st * 1024 + (ob ^ (((ob >> 9) & 1) << 5)); }
__host__ __device__ __forceinline__ void stage_rc(int b, int& R, int& C) { const int st = b / 1024, sb = b % 1024, swz = sb ^ (((sb >> 9) & 1) << 5); R = (st >> 1) * 16 + swz / 64; C = (st & 1) * 32 + (swz % 64) / 2; }
__host__ __device__ __forceinline__ int perm32(int rho) { const int n = rho >> 4, i = rho & 15; return 8 * (i >> 2) + 4 * n + (i & 3); }

struct Unit { int pm, pn; };
struct Gemm { const bf16_t* A; const bf16_t* Bt; int M, N, K; };

struct StaticOrder {
    int nM, nN, nwg, G, c;
    __host__ __device__ void init(int M, int N, int G_, int c_) { nM = M / BM; nN = N / BM; nwg = nM * nN; G = G_; c = c_; }
    __host__ __device__ bool next(int i, Unit& u) const {
        const long L = (long)i * G + c; if (L >= nwg) return false;
        int wgid = (int)L; { const int q = nwg / NXCD, r = nwg % NXCD, xcd = wgid % NXCD, off = wgid / NXCD; wgid = (xcd < r ? xcd * (q + 1) : r * (q + 1) + (xcd - r) * q) + off; }
        const int nig = WGM * nN, gid = wgid / nig, fm = gid * WGM, gsz = (nM - fm) < WGM ? (nM - fm) : WGM;
        u.pm = fm + ((wgid % nig) % gsz); u.pn = (wgid % nig) / gsz; return true;
    }
    __device__ __forceinline__ void a_ready(const Unit&) const {}
    __device__ __forceinline__ void done(const Unit&) const {}
};


__device__ __forceinline__ unsigned cvt_pk_bf16(float lo, float hi) { unsigned r; asm volatile("v_cvt_pk_bf16_f32 %0, %1, %2" : "=v"(r) : "v"(lo), "v"(hi)); return r; }
#define EPI_BAR() do { asm volatile("s_waitcnt lgkmcnt(0)" ::: "memory"); __builtin_amdgcn_s_barrier(); asm volatile("" ::: "memory"); } while (0)
#define OPAQUE(v) asm volatile("" : "+v"(v))
constexpr int EXCH_RSTD = 2048;

__device__ __forceinline__ void panel_rstd(const float* ss, int pm, PG8_LAS float* exch, float (&rs)[2][4], int rl0) {
    int tid = threadIdx.x; OPAQUE(tid);
    const f32x4 v = *(const f32x4*)((const char*)(ss + (size_t)pm * BM * 8) + (unsigned)tid * 16u);
    float s = (v[0] + v[1]) + (v[2] + v[3]); s += __shfl_xor(s, 1);
    if ((tid & 1) == 0) exch[EXCH_RSTD + (tid >> 1)] = __builtin_amdgcn_rsqf(s * (1.0f / 2048.0f) + 1e-6f);
    EPI_BAR();
#pragma unroll
    for (int ai = 0; ai < 2; ++ai)
#pragma unroll
        for (int m = 0; m < 4; ++m) rs[ai][m] = exch[EXCH_RSTD + rl0 + ai * HALF + m * 16];
}
__device__ __forceinline__ void st_bf16x8(char* p, const f32x4 v0, const f32x4 v1) {
    u32x4 w; w.x = cvt_pk_bf16(v0[0], v0[1]); w.y = cvt_pk_bf16(v0[2], v0[3]); w.z = cvt_pk_bf16(v1[0], v1[1]); w.w = cvt_pk_bf16(v1[2], v1[3]); *(u32x4*)p = w;
}
__device__ __forceinline__ void st_f32x8(char* p, const f32x4 v0, const f32x4 v1) { *(f32x4*)p = v0; *(f32x4*)(p + 16) = v1; }

__device__ __forceinline__ void norm256_store(const f32x4 (&acc)[2][2][4][2], const float (&rs)[2][4], const float* g, float osc, bf16_t* obf, unsigned ldb, float* of32, unsigned ldf,
                                              int rl0, int c0  , int wc, int fq, PG8_LAS float* exch) {
#pragma unroll
    for (int ai = 0; ai < 2; ++ai)
#pragma unroll
        for (int m = 0; m < 4; ++m) { float s = 0.f;
#pragma unroll
            for (int bj = 0; bj < 2; ++bj)
#pragma unroll
                for (int n = 0; n < 2; ++n) { const f32x4 x = acc[ai][bj][m][n]; s += (x[0] * x[0] + x[1] * x[1]) + (x[2] * x[2] + x[3] * x[3]); }
            s += __shfl_xor(s, 16); s += __shfl_xor(s, 32);
            if (fq == 0) exch[(rl0 + ai * HALF + m * 16) * 4 + wc] = s; }
    EPI_BAR();
    f32x4 gv[2][2];
#pragma unroll
    for (int bj = 0; bj < 2; ++bj)
#pragma unroll
        for (int n = 0; n < 2; ++n) gv[bj][n] = *(const f32x4*)((const char*)g + (unsigned)(c0 + bj * HALF + 4 * n) * 4u) * osc;
#pragma unroll
    for (int ai = 0; ai < 2; ++ai)
#pragma unroll
        for (int m = 0; m < 4; ++m) { const unsigned rl = rl0 + ai * HALF + m * 16; const f32x4 p = *(const PG8_LAS f32x4*)(exch + rl * 4);
            const float r = rs[ai][m]; const float tot = ((p[0] + p[1]) + (p[2] + p[3])) * r * r; const float rn = __builtin_amdgcn_rsqf(tot * (1.0f / 256.0f) + 1e-6f) * r;
#pragma unroll
            for (int bj = 0; bj < 2; ++bj) { const f32x4 v0 = acc[ai][bj][m][0] * rn * gv[bj][0], v1 = acc[ai][bj][m][1] * rn * gv[bj][1];
                st_bf16x8((char*)obf + (rl * ldb + c0 + bj * HALF) * 2u, v0, v1);
                if (of32) st_f32x8((char*)of32 + (rl * ldf + c0 + bj * HALF) * 4u, v0, v1); } }
}

struct EpiLruIn {
    static constexpr bool PERM = true, AFTER_DRAIN = false;
    const float* ss; bf16_t* gate; bf16_t* xr; bf16_t* mq; float* out; const float* gmq; PG8_LAS float* exch; int j;
    __device__ __forceinline__ void operator()(const f32x4 (&acc)[2][2][4][2], const Unit& u, int wr, int wc, int fr_, int fq_) const {
        int fr = fr_, fq = fq_; OPAQUE(fr); OPAQUE(fq);
        const int rl0 = wr * 64 + fr, c0 = wc * 32 + 8 * fq;
        float rs[2][4]; panel_rstd(ss, u.pm, exch, rs, rl0);
        if (u.pn < 16) {
            char* dst = (char*)((u.pn < 8) ? gate : xr) + ((size_t)u.pm * BM * D + (size_t)(u.pn & 7) * BM) * 2;
#pragma unroll
            for (int ai = 0; ai < 2; ++ai)
#pragma unroll
                for (int m = 0; m < 4; ++m) { const unsigned rl = rl0 + ai * HALF + m * 16; const int row = u.pm * BM + (int)rl; const float r = rs[ai][m];
                    float* so = nullptr;
                    if (u.pn >= 8) { if (row < MP) { const int b = row >> 12, t = row & 4095; if (t >= SEQ - 3) so = out + O_PLC + ((size_t)(j * NBP + b) * 3 + (t - (SEQ - 3))) * D + (size_t)(u.pn & 7) * BM; }
                                     else { const int r2 = row - MP, b = r2 >> 6, t = r2 & 63; if (t >= DSEQ - 3) so = out + O_SLC + ((size_t)(j * NBS + b) * 3 + (t - (DSEQ - 3))) * D + (size_t)(u.pn & 7) * BM; } }
#pragma unroll
                    for (int bj = 0; bj < 2; ++bj) { const f32x4 v0 = acc[ai][bj][m][0] * r, v1 = acc[ai][bj][m][1] * r;
                        st_bf16x8(dst + (rl * D + c0 + bj * HALF) * 2u, v0, v1);
                        if (so) st_f32x8((char*)(so + c0 + bj * HALF), v0, v1); } }
        } else {
            norm256_store(acc, rs, gmq, MQSCALE, mq + (size_t)u.pm * BM * MEMW + (size_t)(u.pn - 16) * 256, MEMW, nullptr, 0, rl0, c0, wc, fq, exch);
        }
    }
};

struct EpiAttIn {
    static constexpr bool PERM = true, AFTER_DRAIN = false;
    const float* ss; bf16_t* qb; bf16_t* kb; bf16_t* vb; bf16_t* mq; float* out; const float* gq; const float* gk; const float* gmq; PG8_LAS float* exch; int j;
    __device__ __forceinline__ void operator()(const f32x4 (&acc)[2][2][4][2], const Unit& u, int wr, int wc, int fr_, int fq_) const {
        int fr = fr_, fq = fq_; OPAQUE(fr); OPAQUE(fq);
        const int rl0 = wr * 64 + fr, c0 = wc * 32 + 8 * fq;
        float rs[2][4]; panel_rstd(ss, u.pm, exch, rs, rl0);
        const size_t orow = (u.pm < MP / BM) ? ((size_t)j * MP + (size_t)u.pm * BM) : ((size_t)j * MS + (size_t)(u.pm * BM - MP));
        if (u.pn < 16) {
            const bool isq = u.pn < 8; const float* g = isq ? gq : gk; const float osc = isq ? QSCALE : 1.0f;
#pragma unroll
            for (int ai = 0; ai < 2; ++ai)
#pragma unroll
                for (int m = 0; m < 4; ++m)
#pragma unroll
                    for (int bj = 0; bj < 2; ++bj) { const f32x4 x = acc[ai][bj][m][0], y = acc[ai][bj][m][1];
                        float s = ((x[0] * x[0] + x[1] * x[1]) + (x[2] * x[2] + x[3] * x[3])) + ((y[0] * y[0] + y[1] * y[1]) + (y[2] * y[2] + y[3] * y[3]));
                        s += __shfl_xor(s, 16); s += __shfl_xor(s, 32);
                        if (fq == 0) exch[((bj * 256) + rl0 + ai * HALF + m * 16) * 4 + wc] = s; }
            EPI_BAR();
            const f32x4 g0 = *(const f32x4*)((const char*)g + (unsigned)c0 * 4u) * osc, g1 = *(const f32x4*)((const char*)g + (unsigned)c0 * 4u + 16u) * osc;
            char* dst = (char*)(isq ? qb : kb) + ((size_t)u.pm * BM * D + (size_t)(u.pn & 7) * BM) * 2;
            char* fo = isq ? nullptr : (char*)(out + ((u.pm < MP / BM) ? O_PAK : O_SAK) + orow * D + (size_t)(u.pn & 7) * BM);
#pragma unroll
            for (int ai = 0; ai < 2; ++ai)
#pragma unroll
                for (int m = 0; m < 4; ++m) { const unsigned rl = rl0 + ai * HALF + m * 16; const float r = rs[ai][m];
#pragma unroll
                    for (int bj = 0; bj < 2; ++bj) { const f32x4 p = *(const PG8_LAS f32x4*)(exch + (bj * 256 + rl) * 4);
                        const float tot = ((p[0] + p[1]) + (p[2] + p[3])) * r * r; const float rn = __builtin_amdgcn_rsqf(tot * (1.0f / 128.0f) + 1e-6f) * r;
                        const f32x4 v0 = acc[ai][bj][m][0] * rn * g0, v1 = acc[ai][bj][m][1] * rn * g1;
                        st_bf16x8(dst + (rl * D + c0 + bj * HALF) * 2u, v0, v1);
                        if (fo) st_f32x8(fo + (rl * D + c0 + bj * HALF) * 4u, v0, v1); } }
        } else if (u.pn < 24) {
            char* dst = (char*)vb + ((size_t)u.pm * BM * D + (size_t)(u.pn - 16) * BM) * 2;
            char* fo = (char*)(out + ((u.pm < MP / BM) ? O_PAV : O_SAV) + orow * D + (size_t)(u.pn - 16) * BM);
#pragma unroll
            for (int ai = 0; ai < 2; ++ai)
#pragma unroll
                for (int m = 0; m < 4; ++m) { const unsigned rl = rl0 + ai * HALF + m * 16; const float r = rs[ai][m];
#pragma unroll
                    for (int bj = 0; bj < 2; ++bj) { const f32x4 v0 = acc[ai][bj][m][0] * r, v1 = acc[ai][bj][m][1] * r;
                        st_bf16x8(dst + (rl * D + c0 + bj * HALF) * 2u, v0, v1);
                        st_f32x8(fo + (rl * D + c0 + bj * HALF) * 4u, v0, v1); } }
        } else {
            norm256_store(acc, rs, gmq, MQSCALE, mq + (size_t)u.pm * BM * MEMW + (size_t)(u.pn - 24) * 256, MEMW, nullptr, 0, rl0, c0, wc, fq, exch);
        }
    }
};

struct EpiMemKV {
    static constexpr bool PERM = true, AFTER_DRAIN = false;
    const float* memrs; const float* gk  ; bf16_t* mk; bf16_t* mv; float* out; PG8_LAS float* exch;
    __device__ __forceinline__ void operator()(const f32x4 (&acc)[2][2][4][2], const Unit& u, int wr, int wc, int fr_, int fq_) const {
        int fr = fr_, fq = fq_; OPAQUE(fr); OPAQUE(fq);
        const int rl0 = wr * 64 + fr, c0 = wc * 32 + 8 * fq; const int i = u.pn >> 3, t = u.pn & 7;
        float rs[2][4];
#pragma unroll
        for (int ai = 0; ai < 2; ++ai)
#pragma unroll
            for (int m = 0; m < 4; ++m) rs[ai][m] = *(const float*)((const char*)(memrs + u.pm * BM) + (unsigned)(rl0 + ai * HALF + m * 16) * 4u);
        const size_t tbase = ((size_t)i * 512 + (size_t)u.pm * BM) * MEMW + (size_t)(t & 3) * 256;
        if (t < 4) {
            norm256_store(acc, rs, gk + i * 256, 1.0f, mk + tbase, MEMW, out + O_PMK + tbase, MEMW, rl0, c0, wc, fq, exch);
        } else {
            char* dst = (char*)(mv + tbase); char* fo = (char*)(out + O_PMV + tbase);
#pragma unroll
            for (int ai = 0; ai < 2; ++ai)
#pragma unroll
                for (int m = 0; m < 4; ++m) { const unsigned rl = rl0 + ai * HALF + m * 16; const float r = rs[ai][m];
#pragma unroll
                    for (int bj = 0; bj < 2; ++bj) { const f32x4 v0 = acc[ai][bj][m][0] * r, v1 = acc[ai][bj][m][1] * r;
                        st_bf16x8(dst + (rl * MEMW + c0 + bj * HALF) * 2u, v0, v1);
                        st_f32x8(fo + (rl * MEMW + c0 + bj * HALF) * 4u, v0, v1); } }
        }
    }
};

struct EpiResid {
    static constexpr bool PERM = false, AFTER_DRAIN = false;
    const float* base0; const float* base1;
    float* x; bf16_t* xb; float* ssout; PG8_LAS float* exch;
    __device__ __forceinline__ void operator()(const f32x4 (&acc)[2][2][4][2], const Unit& u, int wr, int wc, int fr_, int fq_) const {
        int fr = fr_, fq = fq_; OPAQUE(fr); OPAQUE(fq);
        const unsigned rl0 = wr * 64 + fr, col0 = u.pn * BM + wc * 32 + 4 * fq;
        const char* bp = (const char*)((u.pm < MP / BM) ? base0 + (size_t)u.pm * BM * D : base1 + (size_t)(u.pm * BM - MP) * D);
        char* xp = (char*)(x + (size_t)u.pm * BM * D); char* xbp = (char*)(xb + (size_t)u.pm * BM * D);
#pragma unroll
        for (int ai = 0; ai < 2; ++ai)
#pragma unroll
            for (int m = 0; m < 4; ++m) { const unsigned rl = rl0 + ai * HALF + m * 16; const unsigned o4 = (rl * D + col0) * 4u; float s = 0.f;
#pragma unroll
                for (int bj = 0; bj < 2; ++bj) {
                    const f32x4 b0 = *(const f32x4*)(bp + o4 + (bj * HALF) * 4u), b1 = *(const f32x4*)(bp + o4 + (bj * HALF + 16) * 4u);
                    const f32x4 v0 = b0 + acc[ai][bj][m][0], v1 = b1 + acc[ai][bj][m][1];
                    *(f32x4*)(xp + o4 + (bj * HALF) * 4u) = v0; *(f32x4*)(xp + o4 + (bj * HALF + 16) * 4u) = v1;
                    u32x2 w0, w1; w0.x = cvt_pk_bf16(v0[0], v0[1]); w0.y = cvt_pk_bf16(v0[2], v0[3]); w1.x = cvt_pk_bf16(v1[0], v1[1]); w1.y = cvt_pk_bf16(v1[2], v1[3]);
                    *(u32x2*)(xbp + (o4 >> 1) + (bj * HALF) * 2u) = w0; *(u32x2*)(xbp + (o4 >> 1) + (bj * HALF + 16) * 2u) = w1;
                    s += ((v0[0] * v0[0] + v0[1] * v0[1]) + (v0[2] * v0[2] + v0[3] * v0[3])) + ((v1[0] * v1[0] + v1[1] * v1[1]) + (v1[2] * v1[2] + v1[3] * v1[3])); }
                s += __shfl_xor(s, 16); s += __shfl_xor(s, 32);
                if (fq == 0) exch[rl * 4 + wc] = s;
                asm volatile("" ::: "memory"); }
        EPI_BAR();
        int tid = threadIdx.x; OPAQUE(tid);
        if (tid < 256) { const f32x4 p = *(const PG8_LAS f32x4*)(exch + tid * 4); *(float*)((char*)(ssout + (size_t)u.pm * BM * 8 + u.pn) + (unsigned)tid * 32u) = (p[0] + p[1]) + (p[2] + p[3]); }
    }
};

struct EpiUp {
    static constexpr bool PERM = true, AFTER_DRAIN = false;
    const float* ss; bf16_t* up; float* out; PG8_LAS float* exch; int i;
    __device__ __forceinline__ void operator()(const f32x4 (&acc)[2][2][4][2], const Unit& u, int wr, int wc, int fr_, int fq_) const {
        int fr = fr_, fq = fq_; OPAQUE(fr); OPAQUE(fq);
        const int rl0 = wr * 64 + fr, c0 = wc * 32 + 8 * fq;
        float rs[2][4]; panel_rstd(ss, u.pm, exch, rs, rl0);
        char* dst = (char*)up + ((size_t)u.pm * BM * N_UP + (size_t)u.pn * BM) * 2;
#pragma unroll
        for (int ai = 0; ai < 2; ++ai)
#pragma unroll
            for (int m = 0; m < 4; ++m) { const unsigned rl = rl0 + ai * HALF + m * 16; const int row = u.pm * BM + (int)rl; const float r = rs[ai][m];
                float* so = nullptr;
                if (row < MP) { const int b = row >> 12, t = row & 4095; if (t >= SEQ - 2) so = out + O_PFC + ((size_t)(i * NBP + b) * 2 + (t - (SEQ - 2))) * N_UP + (size_t)u.pn * BM; }
                else { const int r2 = row - MP, b = r2 >> 6, t = r2 & 63; if (t >= DSEQ - 2) so = out + O_SFC + ((size_t)(i * NBS + b) * 2 + (t - (DSEQ - 2))) * N_UP + (size_t)u.pn * BM; }
#pragma unroll
                for (int bj = 0; bj < 2; ++bj) { const f32x4 v0 = acc[ai][bj][m][0] * r, v1 = acc[ai][bj][m][1] * r;
                    st_bf16x8(dst + (rl * N_UP + c0 + bj * HALF) * 2u, v0, v1);
                    if (so) st_f32x8((char*)(so + c0 + bj * HALF), v0, v1); } }
    }
};
template <class Epi, class Sched, bool ALIGN_EPI = false, bool SP2 = false>
__device__ __forceinline__ void gemm_phase(PG8_LAS unsigned char* lds, const Gemm g, const Sched& S, const Epi& E) {
    int tid = threadIdx.x; asm volatile("" : "+v"(tid));
    const int wid = __builtin_amdgcn_readfirstlane(tid >> 6), lane = tid & 63, wr = wid >> 2, wc = wid & 3, fr = lane & 15, fq = lane >> 4;
    const int K = g.K, nt = K / BK;
    unsigned voffA[2], voffB[2];
#pragma unroll
    for (int i = 0; i < 2; ++i) { int R, C; stage_rc(tid * 16 + i * 8192, R, C); const int Rb = Epi::PERM ? ((R & ~31) + perm32(R & 31)) : R;
        voffA[i] = (unsigned)(R * K + C) * 2u; voffB[i] = (unsigned)(Rb * K + C) * 2u; }
    const size_t kstep = (size_t)(BK * 2);
    const size_t hstep = (size_t)HALF * K * 2;
    const size_t tstep = 2 * hstep;
    const unsigned ldsw = (unsigned)wid * 1024u;
    const int aoff = lds_byte(wr * 64 + fr, fq * 8), boff = lds_byte(wc * 32 + fr, fq * 8);
#define PG8_SA(b, h) (((b) * 2 + (h)) * HTB)
#define PG8_SB(b, h) ((4 + (b) * 2 + (h)) * HTB)
#define PG8_STAGE(bufoff, gbase, voff) do { _Pragma("unroll") for (int _i = 0; _i < 2; ++_i) \
        __builtin_amdgcn_global_load_lds((const unsigned*)((const char*)(gbase) + (voff)[_i]), (PG8_LAS unsigned*)(lds + (bufoff) + ldsw + _i * 8192), 16, 0, 0); } while (0)
#define PG8_LDA(dst, b, h) do { _Pragma("unroll") for (int m = 0; m < 4; ++m) _Pragma("unroll") for (int k = 0; k < 2; ++k) dst[m][k] = *(const PG8_LAS bf16x8*)(lds + PG8_SA(b, h) + aoff + m * 2048 + k * 1024); } while (0)
#define PG8_LDB(dst, b, h) do { _Pragma("unroll") for (int n = 0; n < 2; ++n) _Pragma("unroll") for (int k = 0; k < 2; ++k) dst[n][k] = *(const PG8_LAS bf16x8*)(lds + PG8_SB(b, h) + boff + n * 2048 + k * 1024); } while (0)
#define PG8_MMA(ai, bj, At, Bt) do { __builtin_amdgcn_s_setprio(1); _Pragma("unroll") for (int m = 0; m < 4; ++m) _Pragma("unroll") for (int n = 0; n < 2; ++n) _Pragma("unroll") for (int k = 0; k < 2; ++k) \
        acc[ai][bj][m][n] = __builtin_amdgcn_mfma_f32_16x16x32_bf16(Bt[n][k], At[m][k], acc[ai][bj][m][n], 0, 0, 0); __builtin_amdgcn_s_setprio(0); } while (0)
#define PG8_WAIT_V(n) asm volatile("s_waitcnt vmcnt(" #n ")" ::: "memory")
#define PG8_WAIT_L(n) asm volatile("s_waitcnt lgkmcnt(" #n ")" ::: "memory")
#define PG8_BAR __builtin_amdgcn_s_barrier()
#define PG8_SCHED __builtin_amdgcn_sched_barrier(0)
    Unit cur, nxt; int ui = 0;
    if (!S.next(0, cur)) return;
    f32x4 acc[2][2][4][2];
#pragma unroll
    for (int a = 0; a < 2; ++a)
#pragma unroll
        for (int b = 0; b < 2; ++b)
#pragma unroll
            for (int m = 0; m < 4; ++m)
#pragma unroll
                for (int n = 0; n < 2; ++n) acc[a][b][m][n] = (f32x4){0.f, 0.f, 0.f, 0.f};
    bf16x8 At[4][2], B0[2][2], B1[2][2];
    const char* cA = (const char*)g.A + (size_t)cur.pm * tstep; const char* cB = (const char*)g.Bt + (size_t)cur.pn * tstep;
    S.a_ready(cur);
    if constexpr (SP2) {
        PG8_STAGE(PG8_SB(0, 0), cB, voffB); PG8_STAGE(PG8_SB(0, 1), cB + hstep, voffB); PG8_STAGE(PG8_SA(0, 0), cA, voffA); PG8_STAGE(PG8_SA(0, 1), cA + hstep, voffA);
        if (wr == 1) PG8_BAR;
        PG8_WAIT_V(2); PG8_BAR;
        PG8_STAGE(PG8_SB(1, 0), cB + kstep, voffB); PG8_STAGE(PG8_SA(1, 0), cA + kstep, voffA); PG8_STAGE(PG8_SB(1, 1), cB + hstep + kstep, voffB);
        PG8_WAIT_V(6); PG8_BAR;
    } else {
        PG8_STAGE(PG8_SB(0, 0), cB, voffB); PG8_STAGE(PG8_SA(0, 0), cA, voffA); PG8_STAGE(PG8_SB(0, 1), cB + hstep, voffB); PG8_STAGE(PG8_SA(0, 1), cA + hstep, voffA);
        if (wr == 1) PG8_BAR;
        PG8_WAIT_V(4); PG8_BAR;
        PG8_STAGE(PG8_SB(1, 0), cB + kstep, voffB); PG8_STAGE(PG8_SA(1, 0), cA + kstep, voffA); PG8_STAGE(PG8_SB(1, 1), cB + hstep + kstep, voffB);
        PG8_WAIT_V(6); PG8_BAR;
    }
    for (;;) {
        const bool has_next = S.next(ui + 1, nxt);
        const char* nA = has_next ? (const char*)g.A + (size_t)nxt.pm * tstep : cA; const char* nB = has_next ? (const char*)g.Bt + (size_t)nxt.pn * tstep : cB;
        for (int t = 0; t < nt; t += 2) {
            const bool last = (t == nt - 2);
            const char* a1 = cA + (size_t)(t + 1) * kstep;
            const char* a2 = last ? nA : cA + (size_t)(t + 2) * kstep; const char* b2 = last ? nB : cB + (size_t)(t + 2) * kstep;
            const char* a3 = a2 + kstep; const char* b3 = b2 + kstep;
            if (last && has_next) S.a_ready(nxt);
            if constexpr (SP2) {
            PG8_LDB(B0, 0, 0); PG8_LDB(B1, 0, 1); PG8_SCHED; PG8_LDA(At, 0, 0); PG8_STAGE(PG8_SA(1, 1), a1 + hstep, voffA);
            PG8_WAIT_V(8); PG8_WAIT_L(0); PG8_BAR; PG8_MMA(0, 0, At, B0); PG8_MMA(0, 1, At, B1); PG8_BAR; PG8_SCHED;
            PG8_LDA(At, 0, 1); PG8_STAGE(PG8_SB(0, 0), b2, voffB); PG8_STAGE(PG8_SB(0, 1), b2 + hstep, voffB); PG8_STAGE(PG8_SA(0, 0), a2, voffA);
            PG8_WAIT_V(8); PG8_WAIT_L(0); PG8_BAR; PG8_MMA(1, 0, At, B0); PG8_MMA(1, 1, At, B1); PG8_BAR; PG8_SCHED;
            PG8_LDB(B0, 1, 0); PG8_LDB(B1, 1, 1); PG8_SCHED; PG8_LDA(At, 1, 0); PG8_STAGE(PG8_SA(0, 1), a2 + hstep, voffA);
            PG8_WAIT_V(8); PG8_WAIT_L(0); PG8_BAR; PG8_MMA(0, 0, At, B0); PG8_MMA(0, 1, At, B1); PG8_BAR; PG8_SCHED;
            PG8_LDA(At, 1, 1); PG8_STAGE(PG8_SB(1, 0), b3, voffB); PG8_STAGE(PG8_SB(1, 1), b3 + hstep, voffB); PG8_STAGE(PG8_SA(1, 0), a3, voffA);
            PG8_WAIT_V(8); PG8_WAIT_L(0); PG8_BAR; PG8_MMA(1, 0, At, B0); PG8_MMA(1, 1, At, B1); PG8_BAR; PG8_SCHED;
            } else {
            PG8_LDB(B0, 0, 0); PG8_SCHED; PG8_LDA(At, 0, 0); PG8_STAGE(PG8_SA(1, 1), a1 + hstep, voffA);
            PG8_WAIT_L(8); PG8_BAR; PG8_WAIT_L(0); PG8_MMA(0, 0, At, B0); PG8_BAR; PG8_SCHED;
            PG8_LDB(B1, 0, 1); PG8_STAGE(PG8_SB(0, 0), b2, voffB);
            PG8_BAR; PG8_WAIT_L(0); PG8_MMA(0, 1, At, B1); PG8_BAR;
            PG8_LDA(At, 0, 1); PG8_STAGE(PG8_SA(0, 0), a2, voffA);
            PG8_BAR; PG8_WAIT_L(0); PG8_MMA(1, 0, At, B0); PG8_BAR; PG8_SCHED;
            PG8_STAGE(PG8_SB(0, 1), b2 + hstep, voffB);
            PG8_WAIT_V(6); PG8_BAR; PG8_MMA(1, 1, At, B1); PG8_BAR;
            PG8_LDB(B0, 1, 0); PG8_SCHED; PG8_LDA(At, 1, 0); PG8_STAGE(PG8_SA(0, 1), a2 + hstep, voffA);
            PG8_WAIT_L(8); PG8_BAR; PG8_WAIT_L(0); PG8_MMA(0, 0, At, B0); PG8_BAR; PG8_SCHED;
            PG8_LDB(B1, 1, 1); PG8_STAGE(PG8_SB(1, 0), b3, voffB);
            PG8_BAR; PG8_WAIT_L(0); PG8_MMA(0, 1, At, B1); PG8_BAR;
            PG8_LDA(At, 1, 1); PG8_STAGE(PG8_SA(1, 0), a3, voffA);
            PG8_BAR; PG8_WAIT_L(0); PG8_MMA(1, 0, At, B0); PG8_BAR; PG8_SCHED;
            PG8_STAGE(PG8_SB(1, 1), b3 + hstep, voffB);
            PG8_WAIT_V(6); PG8_BAR; PG8_MMA(1, 1, At, B1); PG8_BAR;
            }
        }
        if constexpr (ALIGN_EPI) { if (wr == 0) PG8_BAR; }
        if constexpr (!Epi::AFTER_DRAIN) { E(acc, cur, wr, wc, fr, fq); S.done(cur); }
        if (!has_next) break;
#pragma unroll
        for (int a = 0; a < 2; ++a)
#pragma unroll
            for (int b = 0; b < 2; ++b)
#pragma unroll
                for (int m = 0; m < 4; ++m)
#pragma unroll
                    for (int n = 0; n < 2; ++n) acc[a][b][m][n] = (f32x4){0.f, 0.f, 0.f, 0.f};
        cur = nxt; cA = nA; cB = nB; ++ui;
        if constexpr (ALIGN_EPI) { if (wr == 1) PG8_BAR; }
    }
    PG8_WAIT_V(0);
    if constexpr (!ALIGN_EPI) { if (wr == 0) PG8_BAR; }
    PG8_BAR;
    if constexpr (Epi::AFTER_DRAIN) { E.fused(acc, cur, wr, wc, fr, fq, lds, wid, lane); S.done(cur); }
#undef PG8_SA
#undef PG8_SB
#undef PG8_STAGE
#undef PG8_LDA
#undef PG8_LDB
#undef PG8_MMA
#undef PG8_WAIT_V
#undef PG8_WAIT_L
#undef PG8_BAR
#undef PG8_SCHED
}
}
#define XB_TMO      128
#define XB_XCNT(j)  (256  + 64 * (j))
#define XB_XSUB(j)  (1280 + 64 * (j))
#define XB_XGEN(j)  (2304 + 64 * (j))
#define XB_TOP      3328
#define XB_TOPGEN   3392
#define XCD_BAR_WORDS 3456
#define XB_SPIN_CAP (1u << 18)

__device__ __forceinline__ unsigned xb_ld(unsigned* p)              { return __hip_atomic_load(p, __ATOMIC_RELAXED, __HIP_MEMORY_SCOPE_AGENT); }
__device__ __forceinline__ unsigned xb_add(unsigned* p, unsigned v) { return __hip_atomic_fetch_add(p, v, __ATOMIC_RELAXED, __HIP_MEMORY_SCOPE_AGENT); }
__device__ __forceinline__ unsigned xb_xcc_id() { return (unsigned)__builtin_amdgcn_s_getreg((3 << 11) | 20) & 0xFu; }
#define XB_SPIN(cond, bar) do { unsigned _sp = 0; while (cond) { __builtin_amdgcn_s_sleep(1); \
    if ((++_sp & 255u) == 0u) { if (xb_ld(&(bar)[XB_TMO])) break; if (_sp > XB_SPIN_CAP) { atomicAdd(&(bar)[XB_TMO], 1u); break; } } } } while (0)

struct XcdBarrier {
    unsigned* bar; unsigned x;
    volatile LAS unsigned* st;
};

__device__ __forceinline__ XcdBarrier xcd_barrier_post(unsigned* bar, volatile LAS unsigned* st) {
    XcdBarrier b; b.bar = bar; b.x = xb_xcc_id(); b.st = st;
    if (threadIdx.x == 0) (void)xb_add(&bar[XB_XCNT(b.x)], 1u);
    return b;
}
__device__ __forceinline__ void xcd_barrier_complete(unsigned* bar, unsigned x, unsigned& nloc, unsigned& nx) {
    const unsigned G = gridDim.x * gridDim.y * gridDim.z;
    unsigned sum, cnt, mine, sp = 0u;
    for (;;) {
        sum = 0u; cnt = 0u; mine = 0u;
#pragma unroll
        for (unsigned j = 0; j < 16; ++j) { const unsigned c = xb_ld(&bar[XB_XCNT(j)]); sum += c; cnt += (c > 0u) ? 1u : 0u; mine = (j == x) ? c : mine; }
        if (sum == G) break;
        __builtin_amdgcn_s_sleep(1);
        if ((++sp & 255u) == 0u) { if (xb_ld(&bar[XB_TMO])) break; if (sp > XB_SPIN_CAP) { atomicAdd(&bar[XB_TMO], 1u); break; } }
    }
    nloc = mine > 0u ? mine : 1u; nx = cnt > 0u ? cnt : 1u;
}

__device__ __forceinline__ void xcd_barrier(const XcdBarrier& b) {
    asm volatile("s_waitcnt vmcnt(0)" ::: "memory");
    __syncthreads();
    if (threadIdx.x == 0) {
        unsigned* bar = b.bar;
        __builtin_amdgcn_s_waitcnt(0);
        unsigned nloc = b.st[0], nx = b.st[1];
        if (nloc == 0u) { xcd_barrier_complete(bar, b.x, nloc, nx); b.st[0] = nloc; b.st[1] = nx; }
        const unsigned old = xb_add(&bar[XB_XSUB(b.x)], 1u);
        const unsigned gen = old / nloc;
        if (old + 1u == (gen + 1u) * nloc) {
            __builtin_amdgcn_fence(__ATOMIC_RELEASE, "agent");
            asm volatile("s_waitcnt vmcnt(0)" ::: "memory");
            const unsigned og = xb_add(&bar[XB_TOP], 1u);
            const unsigned tg = og / nx;
            if (og + 1u == (tg + 1u) * nx) xb_add(&bar[XB_TOPGEN], 1u);
            else XB_SPIN(xb_ld(&bar[XB_TOPGEN]) == tg, bar);
            __builtin_amdgcn_fence(__ATOMIC_ACQUIRE, "agent");
            xb_add(&bar[XB_XGEN(b.x)], 1u);
            asm volatile("s_waitcnt vmcnt(0)" ::: "memory");
        } else {
            XB_SPIN(xb_ld(&bar[XB_XGEN(b.x)]) == gen, bar);
            __builtin_amdgcn_fence(__ATOMIC_ACQUIRE, "agent");
            asm volatile("s_waitcnt vmcnt(0)" ::: "memory");
        }
    }
    __syncthreads();
}

struct Args { const float* in[N_INPUTS]; float* out; unsigned char* ws; int ph_lo, ph_hi; };
static_assert(sizeof(Args) == N_INPUTS * 8 + 8 + 8 + 8, "Args has no padding");

__device__ __forceinline__ unsigned long long ldptr(const LAS unsigned long long* t, int k) {
    const unsigned long long v = t[k]; const unsigned lo = __builtin_amdgcn_readfirstlane((unsigned)v), hi = __builtin_amdgcn_readfirstlane((unsigned)(v >> 32)); return ((unsigned long long)hi << 32) | lo; }
struct Frame {
    LAS unsigned char* lds; int tid, lane, wave, G, gw, ngw; long gtid, nthreads;
};

__device__ __forceinline__ void p0_transpose_item(const float* W, int K, int N, bf16_t* WT, const float* gain, LAS float* scr, int item, int lane) {
    const int nblk = N / 32, kb = item / nblk, nb = item % nblk, k0 = 64 * kb, n0 = 32 * nb;
#pragma unroll 8
    for (int i = 0; i < 32; ++i) { const int kk = 2 * i + (lane >> 5); float v = W[(size_t)(k0 + kk) * N + n0 + (lane & 31)]; if (gain) v *= gain[k0 + kk]; scr[kk * 33 + (lane & 31)] = v; }
    LDS_WAIT(); asm volatile("" ::: "memory");
    const int c = lane & 7;
#pragma unroll
    for (int j = 0; j < 4; ++j) { const int n = (lane >> 3) + 8 * j; const LAS float* s = scr + (8 * c) * 33 + n;
        u32x4 o; o.x = pk2(s[0 * 33], s[1 * 33]); o.y = pk2(s[2 * 33], s[3 * 33]); o.z = pk2(s[4 * 33], s[5 * 33]); o.w = pk2(s[6 * 33], s[7 * 33]);
        *(u32x4*)(WT + (size_t)(n0 + n) * K + k0 + 8 * c) = o; }
    LDS_WAIT(); asm volatile("" ::: "memory");
}
struct Mat { const float* W; int K, N; bf16_t* WT; const float* gain; };
__device__ __forceinline__ Mat get_mat(const Args& a, int id) {
    Mat m; unsigned char* ws = a.ws;
    if (id < 2)       { m.W = a.in[I_LWIN] + (size_t)id * D * N_IN_LRU; m.K = D; m.N = N_IN_LRU; m.WT = (bf16_t*)(ws + WS_WINL + id * SZ_WINL); m.gain = a.in[I_NMIX] + (2 * id) * D; }
    else if (id < 4)  { const int j = id - 2; m.W = a.in[I_AWIN] + (size_t)j * D * N_IN_ATT; m.K = D; m.N = N_IN_ATT; m.WT = (bf16_t*)(ws + WS_WINA + j * SZ_WINA); m.gain = a.in[I_NMIX] + (2 * j + 1) * D; }
    else if (id < 8)  { const int i = id - 4; m.W = ((i & 1) ? a.in[I_AWOUT] : a.in[I_LWOUT]) + (size_t)(i >> 1) * K_OUT * D; m.K = K_OUT; m.N = D; m.WT = (bf16_t*)(ws + WS_WOUT + i * SZ_WOUT); m.gain = nullptr; }
    else if (id < 12) { const int i = id - 8; m.W = a.in[I_FUP] + (size_t)i * D * N_UP; m.K = D; m.N = N_UP; m.WT = (bf16_t*)(ws + WS_WUP + i * SZ_WUP); m.gain = a.in[I_NFFN] + i * D; }
    else if (id < 16) { const int i = id - 12; m.W = a.in[I_FDN] + (size_t)i * DFF * D; m.K = DFF; m.N = D; m.WT = (bf16_t*)(ws + WS_WDN + i * SZ_WDN); m.gain = nullptr; }
    else if (id < 20) { const int i = id - 16; m.W = a.in[I_MWKV] + (size_t)i * D * 2048; m.K = D; m.N = 2048; m.WT = (bf16_t*)(ws + WS_WKV) + (size_t)i * 2048 * D; m.gain = a.in[I_MNORM] + i * D; }
    else { const int g = id - 20, j = g >> 4, h = (g >> 1) & 7, which = g & 1;
        m.W = (which ? a.in[I_LGXW] : a.in[I_LGAW]) + (size_t)(j * 8 + h) * 256 * 256; m.K = 256; m.N = 256; m.WT = (bf16_t*)(ws + WS_WG + j * SZ_WG) + ((size_t)h * 512 + which * 256) * 256; m.gain = nullptr; }
    return m;
}
constexpr int N_MATS = 52;

__device__ __forceinline__ void p0_prologue(const Args& a, const Frame& F) {
    unsigned char* ws = a.ws;
    LAS float* scr = (LAS float*)(F.lds + F.wave * 16384);
    int rot = 0;
    for (int id = 0; id < N_MATS; ++id) {
        const Mat m = get_mat(a, id); const int nitems = (m.K / 64) * (m.N / 32);
        int first = F.gw - rot; if (first < 0) first += F.ngw;
        for (int it = first; it < nitems; it += F.ngw) p0_transpose_item(m.W, m.K, m.N, m.WT, m.gain, scr, it, F.lane);
        rot = (rot + nitems) % F.ngw;
    }
    {
        bf16_t* xb = (bf16_t*)(ws + WS_XB); float* ssa = (float*)(ws + WS_SSA);
        for (int m = F.gw; m < M; m += F.ngw) {
            const float* src = (m < MP) ? a.in[I_XP] + (size_t)m * D : a.in[I_XS] + (size_t)(m - MP) * D;
            const f32x4* xr = (const f32x4*)src + F.lane; u32x2* o = (u32x2*)(xb + (size_t)m * D) + F.lane; float s = 0.f;
#pragma unroll
            for (int j = 0; j < 8; ++j) { const f32x4 v = xr[64 * j]; s += (v[0] * v[0] + v[1] * v[1]) + (v[2] * v[2] + v[3] * v[3]); u32x2 w; w.x = pk2(v[0], v[1]); w.y = pk2(v[2], v[3]); o[64 * j] = w; }
            s = wave_sum(s);
            if (F.lane < 8) ssa[(size_t)m * 8 + F.lane] = (F.lane == 0) ? s : 0.f;
        }
    }
    {
        bf16_t* mb = (bf16_t*)(ws + WS_MEMB); float* mrs = (float*)(ws + WS_MEMRS);
        for (int m = F.gw; m < 512; m += F.ngw) {
            const f32x4* xr = (const f32x4*)(a.in[I_MEM] + (size_t)m * D) + F.lane; u32x2* o = (u32x2*)(mb + (size_t)m * D) + F.lane; float s = 0.f;
#pragma unroll
            for (int j = 0; j < 8; ++j) { const f32x4 v = xr[64 * j]; s += (v[0] * v[0] + v[1] * v[1]) + (v[2] * v[2] + v[3] * v[3]); u32x2 w; w.x = pk2(v[0], v[1]); w.y = pk2(v[2], v[3]); o[64 * j] = w; }
            s = wave_sum(s);
            if (F.lane == 0) mrs[m] = 1.0f / sqrtf(s * (1.0f / 2048.0f) + EPS);
        }
    }
    {
        const size_t n4[4] = {(size_t)2 * NBS * PAST * D / 4, (size_t)2 * NBS * PAST * D / 4, (size_t)4 * NBS * MEMT * MEMW / 4, (size_t)4 * NBS * MEMT * MEMW / 4};
        const float* srcs[4] = {a.in[I_CAK], a.in[I_CAV], a.in[I_CMK], a.in[I_CMV]};
        unsigned char* dsts[4] = {ws + WS_CAK, ws + WS_CAV, ws + WS_CMK, ws + WS_CMV};
#pragma unroll
        for (int q = 0; q < 4; ++q) { const f32x4* s = (const f32x4*)srcs[q]; u32x2* d = (u32x2*)dsts[q];
            for (size_t i = (size_t)F.gtid; i < n4[q]; i += (size_t)F.nthreads) { const f32x4 v = s[i]; u32x2 w; w.x = pk2(v[0], v[1]); w.y = pk2(v[2], v[3]); d[i] = w; } }
    }
    {
        float* cl8 = (float*)(ws + WS_CL8);
        for (long i = F.gtid; i < 2 * 2048; i += F.nthreads) { const float L = a.in[I_LLAM][i]; cl8[i] = 8.0f * (fminf(L, 0.f) - log1pf(expf(-fabsf(L)))); }
    }
}

__device__ __forceinline__ void ffn_act_phase(const Args& a, const Frame& F, int i) {
    const bf16_t* up = (const bf16_t*)(a.ws + WS_UP); bf16_t* act = (bf16_t*)(a.ws + WS_ACT);
    const float* cw = a.in[I_FCW] + (size_t)i * 3 * N_UP; const float* cb = a.in[I_FCB] + (size_t)i * N_UP; const float* st = a.in[I_SFC] + (size_t)i * NBS * 2 * N_UP;
    constexpr int NCH = DFF / 8, NRG = M / 8;
    for (long item = F.gtid; item < (long)NRG * NCH; item += F.nthreads) {
        const int rgp = (int)(item / NCH), cc = (int)(item % NCH), c0 = cc * 8, row0 = rgp * 8;
        float wg[3][8], wu[3][8], bg[8], bu[8];
#pragma unroll
        for (int k = 0; k < 3; ++k)
#pragma unroll
            for (int h = 0; h < 2; ++h) { const f32x4 g4 = *(const f32x4*)(cw + (size_t)k * N_UP + c0 + 4 * h), u4 = *(const f32x4*)(cw + (size_t)k * N_UP + DFF + c0 + 4 * h);
#pragma unroll
                for (int e = 0; e < 4; ++e) { wg[k][4 * h + e] = g4[e]; wu[k][4 * h + e] = u4[e]; } }
#pragma unroll
        for (int h = 0; h < 2; ++h) { const f32x4 g4 = *(const f32x4*)(cb + c0 + 4 * h), u4 = *(const f32x4*)(cb + DFF + c0 + 4 * h);
#pragma unroll
            for (int e = 0; e < 4; ++e) { bg[4 * h + e] = g4[e]; bu[4 * h + e] = u4[e]; } }
        float g2[8], g1[8], u2[8], u1[8];
        int t0, b; bool sample;
        if (row0 < MP) { b = row0 >> 12; t0 = row0 & 4095; sample = false; } else { const int r2 = row0 - MP; b = r2 >> 6; t0 = r2 & 63; sample = true; }
        if (t0 == 0) {
            if (sample) {
#pragma unroll
                for (int h = 0; h < 2; ++h) { const float* s0 = st + ((size_t)b * 2 + 0) * N_UP, *s1 = st + ((size_t)b * 2 + 1) * N_UP;
                    const f32x4 a0 = *(const f32x4*)(s0 + c0 + 4 * h), a1 = *(const f32x4*)(s1 + c0 + 4 * h), b0 = *(const f32x4*)(s0 + DFF + c0 + 4 * h), b1 = *(const f32x4*)(s1 + DFF + c0 + 4 * h);
#pragma unroll
                    for (int e = 0; e < 4; ++e) { g2[4 * h + e] = a0[e]; g1[4 * h + e] = a1[e]; u2[4 * h + e] = b0[e]; u1[4 * h + e] = b1[e]; } }
            } else {
#pragma unroll
                for (int e = 0; e < 8; ++e) { g2[e] = 0.f; g1[e] = 0.f; u2[e] = 0.f; u1[e] = 0.f; }
            }
        } else {
            const u32x4 a0 = *(const u32x4*)(up + (size_t)(row0 - 2) * N_UP + c0), a1 = *(const u32x4*)(up + (size_t)(row0 - 1) * N_UP + c0);
            const u32x4 b0 = *(const u32x4*)(up + (size_t)(row0 - 2) * N_UP + DFF + c0), b1 = *(const u32x4*)(up + (size_t)(row0 - 1) * N_UP + DFF + c0);
#pragma unroll
            for (int e = 0; e < 4; ++e) { g2[2 * e] = bf_lo(a0[e]); g2[2 * e + 1] = bf_hi(a0[e]); g1[2 * e] = bf_lo(a1[e]); g1[2 * e + 1] = bf_hi(a1[e]);
                                          u2[2 * e] = bf_lo(b0[e]); u2[2 * e + 1] = bf_hi(b0[e]); u1[2 * e] = bf_lo(b1[e]); u1[2 * e + 1] = bf_hi(b1[e]); }
        }
#pragma unroll
        for (int r = 0; r < 8; ++r) {
            const u32x4 ga = *(const u32x4*)(up + (size_t)(row0 + r) * N_UP + c0), ua = *(const u32x4*)(up + (size_t)(row0 + r) * N_UP + DFF + c0);
            float gc[8], uc[8], o[8];
#pragma unroll
            for (int e = 0; e < 4; ++e) { gc[2 * e] = bf_lo(ga[e]); gc[2 * e + 1] = bf_hi(ga[e]); uc[2 * e] = bf_lo(ua[e]); uc[2 * e + 1] = bf_hi(ua[e]); }
#pragma unroll
            for (int e = 0; e < 8; ++e) { const float yg = bg[e] + wg[0][e] * g2[e] + wg[1][e] * g1[e] + wg[2][e] * gc[e], yu = bu[e] + wu[0][e] * u2[e] + wu[1][e] * u1[e] + wu[2][e] * uc[e];
                o[e] = gelu_tanh(yg) * yu; g2[e] = g1[e]; g1[e] = gc[e]; u2[e] = u1[e]; u1[e] = uc[e]; }
            u32x4 w; w.x = pk2(o[0], o[1]); w.y = pk2(o[2], o[3]); w.z = pk2(o[4], o[5]); w.w = pk2(o[6], o[7]);
            *(u32x4*)(act + (size_t)(row0 + r) * DFF + c0) = w;
        }
    }
}

__device__ __forceinline__ void lru_b_phase(const Args& a, const Frame& F, int j) {
    const float* hloc = (const float*)(a.ws + WS_HLOC); const float* pcum = (const float*)(a.ws + WS_PCUM);
    const float* agga = (const float*)(a.ws + WS_AGGA); const float* aggh = (const float*)(a.ws + WS_AGGH);
    const bf16_t* gate = (const bf16_t*)(a.ws + WS_Z0); bf16_t* aout = (bf16_t*)(a.ws + WS_AOUT);
    for (long item = F.gtid; item < 144L * 512; item += F.nthreads) {
        const int rt = (int)(item >> 9), ch = ((int)item & 511) * 4;
        f32x4 H; int b; float* so = nullptr;
        if (rt < 128) { b = rt >> 6; const int q = rt & 63; H = (f32x4){0.f, 0.f, 0.f, 0.f};
            for (int p = 0; p < q; ++p) { const f32x4 A = *(const f32x4*)(agga + (size_t)(b * 64 + p) * D + ch), Hh = *(const f32x4*)(aggh + (size_t)(b * 64 + p) * D + ch); H = A * H + Hh; }
            if (q == 63) so = a.out + O_PLH + (size_t)(j * NBP + b) * D + ch;
        } else { b = rt - 128; H = *(const f32x4*)(a.in[I_SLH] + (size_t)(j * NBS + b) * D + ch); so = a.out + O_SLH + (size_t)(j * NBS + b) * D + ch; }
        for (int r = 0; r < 64; ++r) { const size_t row = (size_t)rt * 64 + r;
            const f32x4 hl = *(const f32x4*)(hloc + row * D + ch), pc = *(const f32x4*)(pcum + row * D + ch); const u32x2 gt = *(const u32x2*)(gate + row * D + ch);
            const f32x4 hv = hl + pc * H;
            const float m0 = gelu_tanh(bf_lo(gt.x)) * hv[0], m1 = gelu_tanh(bf_hi(gt.x)) * hv[1], m2 = gelu_tanh(bf_lo(gt.y)) * hv[2], m3 = gelu_tanh(bf_hi(gt.y)) * hv[3];
            u32x2 w; w.x = pk2(m0, m1); w.y = pk2(m2, m3); *(u32x2*)(aout + row * K_OUT + ch) = w;
            if (r == 63 && so) *(f32x4*)so = hv; }
    }
}

#define WG_BAR() do { asm volatile("s_waitcnt lgkmcnt(0)" ::: "memory"); __builtin_amdgcn_s_barrier(); asm volatile("" ::: "memory"); } while (0)
constexpr int KSTR = 528, VSTR = 544;
constexpr int KT_BYTES = 64 * KSTR, VT_BYTES = 64 * VSTR, TILE_BYTES = KT_BYTES + VT_BYTES;
static_assert(2 * TILE_BYTES <= LDS_MISC, "attention LDS");
typedef short v4i16_t __attribute__((ext_vector_type(4)));
__device__ __forceinline__ f32x4 mfma16(bf16x8 a, bf16x8 b, f32x4 c) { return __builtin_amdgcn_mfma_f32_16x16x32_bf16(a, b, c, 0, 0, 0); }
__device__ __forceinline__ s16x4 vtr(const LAS unsigned char* p) { return __builtin_bit_cast(s16x4, __builtin_amdgcn_ds_read_tr16_b64_v4i16((LAS v4i16_t*)p)); }
__device__ __forceinline__ unsigned cvtpk(float lo, float hi) { unsigned r; asm volatile("v_cvt_pk_bf16_f32 %0, %1, %2" : "=v"(r) : "v"(lo), "v"(hi)); return r; }

struct AttnU {
    const bf16_t* Q; int ldq;
    const bf16_t* K0; const bf16_t* V0; int ld0; int nt0;
    const bf16_t* K1; const bf16_t* V1; int ld1;
    int nt, stagger, nqw;
    bf16_t* O; int ldo;
    float lam, osc; const float* gsub;
};
__device__ __forceinline__ void tile_load(const bf16_t* base, int ld, int tid, u32x4 (&r)[4]) {
#pragma unroll
    for (int i = 0; i < 4; ++i) { const int id = tid + 512 * i, row = id >> 5, cc = id & 31; r[i] = *(const u32x4*)(base + (size_t)row * ld + cc * 8); }
}
__device__ __forceinline__ void tile_commit(LAS unsigned char* dst, int stride, int tid, const u32x4 (&r)[4]) {
#pragma unroll
    for (int i = 0; i < 4; ++i) { const int id = tid + 512 * i, row = id >> 5, cc = id & 31; *(LAS u32x4*)(dst + row * stride + cc * 16) = r[i]; }
}
__device__ __forceinline__ void sm_update(float& m, float& l, const f32x4 (&s)[4]) {
    float tm = fmaxf(fmaxf(s[0][0], s[0][1]), fmaxf(s[0][2], s[0][3]));
#pragma unroll
    for (int k = 1; k < 4; ++k) tm = fmaxf(tm, fmaxf(fmaxf(s[k][0], s[k][1]), fmaxf(s[k][2], s[k][3])));
    const float mn = fmaxf(m, tm); float acc = 0.f;
#pragma unroll
    for (int k = 0; k < 4; ++k) acc += (fexp2(s[k][0] - mn) + fexp2(s[k][1] - mn)) + (fexp2(s[k][2] - mn) + fexp2(s[k][3] - mn));
    l = l * fexp2(m - mn) + acc; m = mn;
}
__device__ __forceinline__ void sm_combine(float& m, float& l) {
    float mo = fmaxf(m, __shfl_xor(m, 16)); mo = fmaxf(mo, __shfl_xor(mo, 32));
    float ls = l * fexp2(m - mo); ls += __shfl_xor(ls, 16); ls += __shfl_xor(ls, 32);
    m = mo; l = 1.0f / ls;
}

template <int MODE  >
__device__ __forceinline__ void attn_unit(LAS unsigned char* lds, const AttnU& u, int tid, int wid, int lane) {
    const int lq = lane & 15, g = lane >> 4;
    const bool active = wid < u.nqw;
    const int nvis = u.nt - ((u.stagger && wid < 4) ? 1 : 0);
    bf16x8 qf[8];
    { const bf16_t* qp = u.Q + (size_t)(16 * (active ? wid : 0) + lq) * u.ldq + 8 * g;
#pragma unroll
      for (int ks = 0; ks < 8; ++ks) qf[ks] = *(const bf16x8*)(qp + 32 * ks); }
    float m1 = -INFINITY, m2 = -INFINITY, l1 = 0.f, l2 = 0.f;
    {
        u32x4 kr[4];
        tile_load(u.nt0 > 0 ? u.K0 : u.K1, u.nt0 > 0 ? u.ld0 : u.ld1, tid, kr);
        tile_commit(lds, KSTR, tid, kr);
        WG_BAR();
        for (int kt = 0; kt < u.nt; ++kt) {
            const bool more = kt + 1 < u.nt;
            if (more) { const int k2 = kt + 1; if (k2 < u.nt0) tile_load(u.K0 + (size_t)k2 * 64 * u.ld0, u.ld0, tid, kr); else tile_load(u.K1 + (size_t)(k2 - u.nt0) * 64 * u.ld1, u.ld1, tid, kr); }
            if (active && kt < nvis) {
                const LAS unsigned char* kp = lds + (kt & 1) * TILE_BYTES + lq * KSTR + 16 * g;
                f32x4 s1[4], s2[4];
#pragma unroll
                for (int kb = 0; kb < 4; ++kb) { f32x4 x = {0.f, 0.f, 0.f, 0.f}, y = {0.f, 0.f, 0.f, 0.f};
#pragma unroll
                    for (int ks = 0; ks < 4; ++ks) { x = mfma16(*(const LAS bf16x8*)(kp + kb * 16 * KSTR + 64 * ks), qf[ks], x); y = mfma16(*(const LAS bf16x8*)(kp + kb * 16 * KSTR + 256 + 64 * ks), qf[4 + ks], y); }
                    s1[kb] = x; s2[kb] = y; }
                if (MODE == 0) { sm_update(m1, l1, s1); sm_update(m2, l2, s2); }
                else {
#pragma unroll
                    for (int kb = 0; kb < 4; ++kb) s1[kb] += s2[kb];
                    sm_update(m1, l1, s1); }
            }
            if (more) tile_commit(lds + ((kt + 1) & 1) * TILE_BYTES, KSTR, tid, kr);
            WG_BAR();
        }
    }
    float il1, il2 = 0.f;
    { float l = l1; sm_combine(m1, l); il1 = l; if (MODE == 0) { float q = l2; sm_combine(m2, q); il2 = q * u.lam; } }
    f32x4 o[16];
#pragma unroll
    for (int db = 0; db < 16; ++db) o[db] = (f32x4){0.f, 0.f, 0.f, 0.f};
    {
        u32x4 kr[4], vr[4];
        tile_load(u.nt0 > 0 ? u.K0 : u.K1, u.nt0 > 0 ? u.ld0 : u.ld1, tid, kr);
        tile_load(u.nt0 > 0 ? u.V0 : u.V1, u.nt0 > 0 ? u.ld0 : u.ld1, tid, vr);
        tile_commit(lds, KSTR, tid, kr); tile_commit(lds + KT_BYTES, VSTR, tid, vr);
        WG_BAR();
        const int qq = lq >> 2, p = lane & 3;
        for (int kt = 0; kt < u.nt; ++kt) {
            const bool more = kt + 1 < u.nt;
            if (more) { const int k2 = kt + 1;
                if (k2 < u.nt0) { tile_load(u.K0 + (size_t)k2 * 64 * u.ld0, u.ld0, tid, kr); tile_load(u.V0 + (size_t)k2 * 64 * u.ld0, u.ld0, tid, vr); }
                else { tile_load(u.K1 + (size_t)(k2 - u.nt0) * 64 * u.ld1, u.ld1, tid, kr); tile_load(u.V1 + (size_t)(k2 - u.nt0) * 64 * u.ld1, u.ld1, tid, vr); } }
            if (active && kt < nvis) {
                const LAS unsigned char* kp = lds + (kt & 1) * TILE_BYTES + lq * KSTR + 16 * g;
                const LAS unsigned char* vp = lds + (kt & 1) * TILE_BYTES + KT_BYTES + (4 * g + qq) * VSTR + 8 * p;
#pragma unroll
                for (int s2i = 0; s2i < 2; ++s2i) {
                    f32x4 w[2];
#pragma unroll
                    for (int kk = 0; kk < 2; ++kk) { const int kb = 2 * s2i + kk; f32x4 x = {0.f, 0.f, 0.f, 0.f}, y = {0.f, 0.f, 0.f, 0.f};
#pragma unroll
                        for (int ks = 0; ks < 4; ++ks) { x = mfma16(*(const LAS bf16x8*)(kp + kb * 16 * KSTR + 64 * ks), qf[ks], x); y = mfma16(*(const LAS bf16x8*)(kp + kb * 16 * KSTR + 256 + 64 * ks), qf[4 + ks], y); }
#pragma unroll
                        for (int e = 0; e < 4; ++e) w[kk][e] = (MODE == 0) ? fexp2(x[e] - m1) * il1 - fexp2(y[e] - m2) * il2 : fexp2(x[e] + y[e] - m1) * il1; }
                    u32x4 pw; pw.x = cvtpk(w[0][0], w[0][1]); pw.y = cvtpk(w[0][2], w[0][3]); pw.z = cvtpk(w[1][0], w[1][1]); pw.w = cvtpk(w[1][2], w[1][3]);
                    const bf16x8 pb = __builtin_bit_cast(bf16x8, pw);
#pragma unroll
                    for (int db = 0; db < 16; ++db) { const s16x4 lo = vtr(vp + s2i * 32 * VSTR + db * 32), hi = vtr(vp + (s2i * 32 + 16) * VSTR + db * 32);
                        const bf16x8 va = __builtin_shufflevector(lo, hi, 0, 1, 2, 3, 4, 5, 6, 7);
                        o[db] = mfma16(va, pb, o[db]); }
                }
            }
            if (more) { tile_commit(lds + ((kt + 1) & 1) * TILE_BYTES, KSTR, tid, kr); tile_commit(lds + ((kt + 1) & 1) * TILE_BYTES + KT_BYTES, VSTR, tid, vr); }
            WG_BAR();
        }
    }
    if (active) {
        bf16_t* op = u.O + (size_t)(16 * wid + lq) * u.ldo + 4 * g;
        if (MODE == 0) {
            float ss = 0.f;
#pragma unroll
            for (int db = 0; db < 16; ++db) ss += (o[db][0] * o[db][0] + o[db][1] * o[db][1]) + (o[db][2] * o[db][2] + o[db][3] * o[db][3]);
            ss += __shfl_xor(ss, 16); ss += __shfl_xor(ss, 32);
            const float rn = __builtin_amdgcn_rsqf(ss * (1.0f / 256.0f) + EPS) * u.osc;
#pragma unroll
            for (int db = 0; db < 16; ++db) { const f32x4 gv = *(const f32x4*)(u.gsub + 16 * db + 4 * g); const f32x4 v = o[db] * rn * gv;
                u32x2 wv; wv.x = cvtpk(v[0], v[1]); wv.y = cvtpk(v[2], v[3]); *(u32x2*)(op + 16 * db) = wv; }
        } else {
#pragma unroll
            for (int db = 0; db < 16; ++db) { u32x2 wv; wv.x = cvtpk(o[db][0], o[db][1]); wv.y = cvtpk(o[db][2], o[db][3]); *(u32x2*)(op + 16 * db) = wv; }
        }
    }
}

__device__ __forceinline__ void lru_a_unit(const Args& a, LAS unsigned char* lds, int j, int rt, int h, int tid, int wid, int lane) {
    LAS unsigned char* XC = lds;
    const bf16_t* xr = (const bf16_t*)(a.ws + WS_Z1);
    const int lq = lane & 15, g = lane >> 4;
    const int row0 = rt * 64; const bool sample = rt >= 128; const int b = sample ? rt - 128 : rt >> 6; const int pos0 = sample ? 0 : (rt & 63) * 64;
    {
        const int c8 = tid & 31, rg = tid >> 5, ch0 = h * 256 + c8 * 8;
        const float* cw = a.in[I_LCW] + (size_t)j * 4 * D + ch0; const float* cb = a.in[I_LCB] + (size_t)j * D + ch0;
        float w[4][8], bias[8], xv[7][8];
#pragma unroll
        for (int k = 0; k < 4; ++k)
#pragma unroll
            for (int hh = 0; hh < 2; ++hh) { const f32x4 t = *(const f32x4*)(cw + (size_t)k * D + 4 * hh);
#pragma unroll
                for (int e = 0; e < 4; ++e) w[k][4 * hh + e] = t[e]; }
#pragma unroll
        for (int hh = 0; hh < 2; ++hh) { const f32x4 t = *(const f32x4*)(cb + 4 * hh);
#pragma unroll
            for (int e = 0; e < 4; ++e) bias[4 * hh + e] = t[e]; }
#pragma unroll
        for (int d = 0; d < 7; ++d) { const int t = 4 * rg + d - 3;
            if (pos0 + t >= 0) { const u32x4 v = *(const u32x4*)(xr + (size_t)(row0 + t) * D + ch0);
#pragma unroll
                for (int e = 0; e < 4; ++e) { xv[d][2 * e] = bf_lo(v[e]); xv[d][2 * e + 1] = bf_hi(v[e]); } }
            else if (sample) { const float* s = a.in[I_SLC] + ((size_t)(j * NBS + b) * 3 + (3 + t)) * D + ch0; const f32x4 s0 = *(const f32x4*)s, s1 = *(const f32x4*)(s + 4);
#pragma unroll
                for (int e = 0; e < 4; ++e) { xv[d][e] = s0[e]; xv[d][4 + e] = s1[e]; } }
            else {
#pragma unroll
                for (int e = 0; e < 8; ++e) xv[d][e] = 0.f; } }
#pragma unroll
        for (int r = 0; r < 4; ++r) { float y[8];
#pragma unroll
            for (int e = 0; e < 8; ++e) y[e] = bias[e] + w[0][e] * xv[r][e] + w[1][e] * xv[r + 1][e] + w[2][e] * xv[r + 2][e] + w[3][e] * xv[r + 3][e];
            u32x4 pw; pw.x = pk2(y[0], y[1]); pw.y = pk2(y[2], y[3]); pw.z = pk2(y[4], y[5]); pw.w = pk2(y[6], y[7]);
            *(LAS u32x4*)(XC + (4 * rg + r) * KSTR + c8 * 16) = pw; }
    }
    WG_BAR();
    f32x4 ca[4][2], cx[4][2];
#pragma unroll
    for (int mb = 0; mb < 4; ++mb)
#pragma unroll
        for (int nb = 0; nb < 2; ++nb) { ca[mb][nb] = (f32x4){0.f, 0.f, 0.f, 0.f}; cx[mb][nb] = (f32x4){0.f, 0.f, 0.f, 0.f}; }
    {
        const bf16_t* wpa = (const bf16_t*)(a.ws + WS_WG + (size_t)j * SZ_WG) + (size_t)h * 512 * 256 + (size_t)(32 * wid + lq) * 256 + 8 * g;
        const LAS unsigned char* ap = XC + lq * KSTR + 16 * g;
#pragma unroll 2
        for (int ks = 0; ks < 8; ++ks) {
            bf16x8 af[4];
#pragma unroll
            for (int mb = 0; mb < 4; ++mb) af[mb] = *(const LAS bf16x8*)(ap + mb * 16 * KSTR + 64 * ks);
#pragma unroll
            for (int nb = 0; nb < 2; ++nb) { const bf16x8 ba = *(const bf16x8*)(wpa + nb * 16 * 256 + 32 * ks), bx = *(const bf16x8*)(wpa + 256 * 256 + nb * 16 * 256 + 32 * ks);
#pragma unroll
                for (int mb = 0; mb < 4; ++mb) { ca[mb][nb] = mfma16(af[mb], ba, ca[mb][nb]); cx[mb][nb] = mfma16(af[mb], bx, cx[mb][nb]); } }
        }
    }
    float* hloc = (float*)(a.ws + WS_HLOC); float* pcum = (float*)(a.ws + WS_PCUM);
#pragma unroll
    for (int nb = 0; nb < 2; ++nb) {
        const int c = 32 * wid + 16 * nb + lq, ch = h * 256 + c;
        const float ba_ = a.in[I_LGAB][(size_t)j * D + ch], bx_ = a.in[I_LGXB][(size_t)j * D + ch], cl = ((const float*)(a.ws + WS_CL8))[(size_t)j * D + ch] * LOG2E;
        float cA = 1.f, cH = 0.f;
#pragma unroll
        for (int mb = 0; mb < 4; ++mb) {
            float As[4], Hs[4]; float Al = 1.f, Hl = 0.f;
#pragma unroll
            for (int reg = 0; reg < 4; ++reg) { const int t = 16 * mb + 4 * g + reg;
                const float r = sigmoidf_(ca[mb][nb][reg] + ba_), ig = sigmoidf_(cx[mb][nb][reg] + bx_);
                const float av = fexp2(cl * r);
                const float xcv = __builtin_bit_cast(float, (unsigned)(*(const LAS unsigned short*)(XC + t * KSTR + c * 2)) << 16);
                const float gt = sqrtf(fmaxf(1.f - av * av, 0.f)) * (ig * xcv);
                Hl = av * Hl + gt; Al *= av; As[reg] = Al; Hs[reg] = Hl; }
            float Ak[4], Hk[4];
#pragma unroll
            for (int k = 0; k < 4; ++k) { Ak[k] = __shfl(Al, lq + 16 * k); Hk[k] = __shfl(Hl, lq + 16 * k); }
            float PA = cA, PH = cH;
#pragma unroll
            for (int k = 0; k < 3; ++k) if (k < g) { PH = Ak[k] * PH + Hk[k]; PA *= Ak[k]; }
#pragma unroll
            for (int reg = 0; reg < 4; ++reg) { const size_t o = (size_t)(row0 + 16 * mb + 4 * g + reg) * D + ch; hloc[o] = Hs[reg] + As[reg] * PH; pcum[o] = As[reg] * PA; }
#pragma unroll
            for (int k = 0; k < 4; ++k) { cH = Ak[k] * cH + Hk[k]; cA *= Ak[k]; }
        }
        if (g == 0) { ((float*)(a.ws + WS_AGGA))[(size_t)rt * D + ch] = cA; ((float*)(a.ws + WS_AGGH))[(size_t)rt * D + ch] = cH; }
    }
    WG_BAR();
}

template <bool ATT>
__device__ __forceinline__ void mixer_phase(const Args& a, const Frame& F, int i) {
    const int j = i >> 1;
    unsigned char* ws = a.ws;
    unsigned* queue = (unsigned*)(ws + WS_CTL) + CW_QUEUE + 64 * i;
    volatile LAS unsigned* misc = (volatile LAS unsigned*)(F.lds + LDS_MISC);
    const bf16_t* Z0 = (const bf16_t*)(ws + WS_Z0); const bf16_t* Z1 = (const bf16_t*)(ws + WS_Z1); const bf16_t* Z2 = (const bf16_t*)(ws + WS_Z2);
    const bf16_t* MQ = (const bf16_t*)(ws + WS_MQ); bf16_t* AO = (bf16_t*)(ws + WS_AOUT);
    float lam = 0.f, osc = 0.f;
    if (ATT) {
        const float* lp = a.in[I_ALAM] + (size_t)j * 4 * 128;
        float s1 = lp[F.lane] * lp[128 + F.lane] + lp[64 + F.lane] * lp[192 + F.lane], s2 = lp[256 + F.lane] * lp[384 + F.lane] + lp[320 + F.lane] * lp[448 + F.lane];
        s1 = wave_sum(s1); s2 = wave_sum(s2);
        const float lam_init = 0.8f - 0.6f * expf(-0.3f * (float)i);
        lam = expf(s1) - expf(s2) + lam_init; osc = 1.0f - lam_init;
    }
    constexpr int N_FIRST = ATT ? (NBS * 8 + 16 * 32) : (144 * 8);
    constexpr int N_TOTAL = N_FIRST + 256 + 64;
    for (;;) {
        if (F.tid == 0) misc[0] = __hip_atomic_fetch_add(queue, 1u, __ATOMIC_RELAXED, __HIP_MEMORY_SCOPE_AGENT);
        WG_BAR();
        const int idx = (int)misc[0];
        WG_BAR();
        if (idx >= N_TOTAL) break;
        if (idx < N_FIRST) {
            if (ATT) {
                AttnU u; u.ldq = D; u.ld0 = D; u.ld1 = D; u.ldo = K_OUT; u.lam = lam; u.osc = osc; u.gsub = a.in[I_ASUB] + (size_t)j * 256;
                if (idx < NBS * 8) { const int b = idx >> 3, h = idx & 7; const size_t r0 = (size_t)MP + b * DSEQ;
                    u.Q = Z0 + r0 * D + h * 256; u.K0 = (const bf16_t*)(ws + WS_CAK) + ((size_t)(j * NBS + b) * PAST) * D + h * 256; u.V0 = (const bf16_t*)(ws + WS_CAV) + ((size_t)(j * NBS + b) * PAST) * D + h * 256; u.nt0 = PAST / 64;
                    u.K1 = Z1 + r0 * D + h * 256; u.V1 = Z2 + r0 * D + h * 256; u.nt = PAST / 64 + 1; u.stagger = 0; u.nqw = 4; u.O = AO + r0 * K_OUT + h * 256;
                } else { const int k = idx - NBS * 8, qt = 31 - (k >> 4), bh = k & 15, b = bh >> 3, h = bh & 7; const size_t r0 = (size_t)b * SEQ + 128 * qt;
                    u.Q = Z0 + r0 * D + h * 256; u.K0 = nullptr; u.V0 = nullptr; u.nt0 = 0; u.K1 = Z1 + (size_t)b * SEQ * D + h * 256; u.V1 = Z2 + (size_t)b * SEQ * D + h * 256;
                    u.nt = 2 * qt + 2; u.stagger = 1; u.nqw = 8; u.O = AO + r0 * K_OUT + h * 256; }
                attn_unit<0>(F.lds, u, F.tid, F.wave, F.lane);
            } else {
                lru_a_unit(a, F.lds, j, idx >> 3, idx & 7, F.tid, F.wave, F.lane);
            }
        } else {
            AttnU u; u.ldq = MEMW; u.ld0 = MEMW; u.ld1 = MEMW; u.ldo = K_OUT; u.lam = 0.f; u.osc = 1.f; u.gsub = nullptr; u.stagger = 0; u.nt = 4;
            const int k = idx - N_FIRST;
            if (k < 256) { const int b = k >> 7, h = (k >> 5) & 3, qt = k & 31; const size_t r0 = (size_t)b * SEQ + 128 * qt;
                u.Q = MQ + r0 * MEMW + h * 256; u.K0 = nullptr; u.V0 = nullptr; u.nt0 = 0;
                u.K1 = (const bf16_t*)(ws + WS_MEMK) + ((size_t)i * 512 + b * MEMT) * MEMW + h * 256; u.V1 = (const bf16_t*)(ws + WS_MEMV) + ((size_t)i * 512 + b * MEMT) * MEMW + h * 256;
                u.nqw = 8; u.O = AO + r0 * K_OUT + 2048 + h * 256;
            } else { const int k2 = k - 256, b = k2 >> 2, h = k2 & 3; const size_t r0 = (size_t)MP + b * DSEQ;
                u.Q = MQ + r0 * MEMW + h * 256; u.K0 = (const bf16_t*)(ws + WS_CMK) + ((size_t)(i * NBS + b) * MEMT) * MEMW + h * 256; u.V0 = (const bf16_t*)(ws + WS_CMV) + ((size_t)(i * NBS + b) * MEMT) * MEMW + h * 256; u.nt0 = 4;
                u.K1 = u.K0; u.V1 = u.V0; u.nqw = 4; u.O = AO + r0 * K_OUT + 2048 + h * 256; }
            attn_unit<1>(F.lds, u, F.tid, F.wave, F.lane);
        }
    }
}

constexpr int NWAVES = 8;
#ifndef EN
#define EN 0xFFFF
#endif
constexpr int PH_PER_LAYER = 7, N_PHASES = 1 + 4 * PH_PER_LAYER;
#ifndef PG8_SP2
#define PG8_SP2 true
#endif
#ifndef PG8_ALIGN
#define PG8_ALIGN true
#endif

__global__ void __launch_bounds__(NWAVES * 64, 2) fwd_kernel(Args args) {
    extern __shared__ __attribute__((aligned(16))) unsigned char lds_raw[];
#define MAKE_FRAME() Frame F; { int t_ = threadIdx.x; asm volatile("" : "+v"(t_)); F.lds = (LAS unsigned char*)lds_raw; F.tid = t_; F.lane = t_ & 63; F.wave = __builtin_amdgcn_readfirstlane(t_ >> 6); \
        F.G = gridDim.x; F.gw = blockIdx.x * NWAVES + F.wave; F.ngw = F.G * NWAVES; F.gtid = (long)blockIdx.x * (NWAVES * 64) + t_; F.nthreads = (long)F.G * NWAVES * 64; }
    volatile LAS unsigned* MISC = (volatile LAS unsigned*)((LAS unsigned char*)lds_raw + LDS_MISC);
    LAS unsigned long long* ptab = (LAS unsigned long long*)((LAS unsigned char*)lds_raw + LDS_MISC + 128);
    if (threadIdx.x < 32) MISC[threadIdx.x] = 0u;
    if (threadIdx.x < N_INPUTS) ptab[threadIdx.x] = (unsigned long long)args.in[threadIdx.x];
    if (threadIdx.x == 64) { ptab[N_INPUTS] = (unsigned long long)args.out; ptab[N_INPUTS + 1] = (unsigned long long)args.ws; }
    __syncthreads();
#define LOAD_ARGS() Args a; { asm volatile("" ::: "memory"); _Pragma("unroll") for (int k_ = 0; k_ < N_INPUTS; ++k_) a.in[k_] = (const float*)(const GAS float*)ldptr(ptab, k_); \
        a.out = (float*)(GAS float*)ldptr(ptab, N_INPUTS); a.ws = (unsigned char*)(GAS unsigned char*)ldptr(ptab, N_INPUTS + 1); a.ph_lo = 0; a.ph_hi = 0; } unsigned char* const ws = a.ws; \
        const pg8::bf16_t* XB = (const pg8::bf16_t*)(ws + WS_XB); float* ssa = (float*)(ws + WS_SSA); float* ssb = (float*)(ws + WS_SSB); (void)XB; (void)ssa; (void)ssb
#if MK_N_LAUNCHES == 1
    constexpr int lo = 0, hi = N_PHASES;
#else
    const int lo = args.ph_lo, hi = args.ph_hi;
#endif
    XcdBarrier bar; bar.bar = (unsigned*)(args.ws + WS_CTL) + CW_BAR; bar.x = 0; bar.st = nullptr;
    if (hi - lo > 1) bar = xcd_barrier_post((unsigned*)(args.ws + WS_CTL) + CW_BAR, MISC + 8);
#define IN(k) (lo <= (k) && (k) < hi)
#define SEAM(k) do { if (IN(k) && IN((k) + 1)) { asm volatile("" ::: "memory"); XcdBarrier b2_; b2_.bar = (unsigned*)((unsigned char*)(GAS unsigned char*)ldptr(ptab, N_INPUTS + 1) + WS_CTL) + CW_BAR; b2_.x = bar.x; b2_.st = bar.st; xcd_barrier(b2_); } } while (0)
    PG8_LAS unsigned char* glds = (PG8_LAS unsigned char*)lds_raw;
    PG8_LAS float* exch = (PG8_LAS float*)(lds_raw + LDS_EXCH);

    if (IN(0) && (EN & 1)) { MAKE_FRAME(); LOAD_ARGS(); p0_prologue(a, F); }
    SEAM(0);

    for (int i = 0; i < 4; ++i) {
        const int pb = 1 + i * PH_PER_LAYER, j = i >> 1; const bool att = (i & 1) != 0;
        if (IN(pb) && (EN & 2)) {
            LOAD_ARGS();
            if (!att) {
                pg8::Gemm g{XB, (const pg8::bf16_t*)(ws + WS_WINL + j * SZ_WINL), M, N_IN_LRU, D}; pg8::StaticOrder S; S.init(M, N_IN_LRU, (int)gridDim.x, (int)blockIdx.x);
                pg8::EpiLruIn E{ssa, (bf16_t*)(ws + WS_Z0), (bf16_t*)(ws + WS_Z1), (bf16_t*)(ws + WS_MQ), a.out, a.in[I_MQN] + i * 256, exch, j};
                pg8::gemm_phase<pg8::EpiLruIn, pg8::StaticOrder, PG8_ALIGN, PG8_SP2>(glds, g, S, E);
                if (i == 0) {
                    pg8::Gemm g2{(const pg8::bf16_t*)(ws + WS_MEMB), (const pg8::bf16_t*)(ws + WS_WKV), 512, 8192, D}; pg8::StaticOrder S2; S2.init(512, 8192, (int)gridDim.x, (int)blockIdx.x);
                    pg8::EpiMemKV E2{(const float*)(ws + WS_MEMRS), a.in[I_MKN], (bf16_t*)(ws + WS_MEMK), (bf16_t*)(ws + WS_MEMV), a.out, exch};
                    pg8::gemm_phase<pg8::EpiMemKV, pg8::StaticOrder, PG8_ALIGN, PG8_SP2>(glds, g2, S2, E2);
                }
            } else {
                pg8::Gemm g{XB, (const pg8::bf16_t*)(ws + WS_WINA + j * SZ_WINA), M, N_IN_ATT, D}; pg8::StaticOrder S; S.init(M, N_IN_ATT, (int)gridDim.x, (int)blockIdx.x);
                pg8::EpiAttIn E{ssa, (bf16_t*)(ws + WS_Z0), (bf16_t*)(ws + WS_Z1), (bf16_t*)(ws + WS_Z2), (bf16_t*)(ws + WS_MQ), a.out,
                                a.in[I_AQN] + j * 128, a.in[I_AKN] + j * 128, a.in[I_MQN] + i * 256, exch, j};
                pg8::gemm_phase<pg8::EpiAttIn, pg8::StaticOrder, PG8_ALIGN, PG8_SP2>(glds, g, S, E);
            }
        }
        SEAM(pb);
        if (IN(pb + 1) && (EN & 4)) { MAKE_FRAME(); LOAD_ARGS(); if (att) { if (EN & 64) mixer_phase<true>(a, F, i); } else { if (EN & 128) mixer_phase<false>(a, F, i); } }
        SEAM(pb + 1);
        if (IN(pb + 2) && (EN & 8)) { MAKE_FRAME(); LOAD_ARGS(); if (!att) lru_b_phase(a, F, j); }
        if (!att) SEAM(pb + 2);
        if (IN(pb + 3) && (EN & 16)) {
            LOAD_ARGS();
            pg8::Gemm g{(const pg8::bf16_t*)(ws + WS_AOUT), (const pg8::bf16_t*)(ws + WS_WOUT + i * SZ_WOUT), M, D, K_OUT}; pg8::StaticOrder S; S.init(M, D, (int)gridDim.x, (int)blockIdx.x);
            const float* b0 = (i == 0) ? a.in[I_XP] : a.out + O_Y; const float* b1 = (i == 0) ? a.in[I_XS] : a.out + O_Y + (size_t)MP * D;
            pg8::EpiResid E{b0, b1, a.out + O_Y, (bf16_t*)(ws + WS_XB), ssb, exch};
            pg8::gemm_phase<pg8::EpiResid, pg8::StaticOrder, PG8_ALIGN, PG8_SP2>(glds, g, S, E);
        }
        SEAM(pb + 3);
        if (IN(pb + 4) && (EN & 32)) {
            LOAD_ARGS();
            pg8::Gemm g{XB, (const pg8::bf16_t*)(ws + WS_WUP + i * SZ_WUP), M, N_UP, D}; pg8::StaticOrder S; S.init(M, N_UP, (int)gridDim.x, (int)blockIdx.x);
            pg8::EpiUp E{ssb, (bf16_t*)(ws + WS_UP), a.out, exch, i};
            pg8::gemm_phase<pg8::EpiUp, pg8::StaticOrder, PG8_ALIGN, PG8_SP2>(glds, g, S, E);
        }
        SEAM(pb + 4);
        if (IN(pb + 5) && (EN & 256)) { MAKE_FRAME(); LOAD_ARGS(); ffn_act_phase(a, F, i); }
        SEAM(pb + 5);
        if (IN(pb + 6) && (EN & 512)) {
            LOAD_ARGS();
            pg8::Gemm g{(const pg8::bf16_t*)(ws + WS_ACT), (const pg8::bf16_t*)(ws + WS_WDN + i * SZ_WDN), M, D, DFF}; pg8::StaticOrder S; S.init(M, D, (int)gridDim.x, (int)blockIdx.x);
            pg8::EpiResid E{a.out + O_Y, a.out + O_Y + (size_t)MP * D, a.out + O_Y, (bf16_t*)(ws + WS_XB), ssa, exch};
            pg8::gemm_phase<pg8::EpiResid, pg8::StaticOrder, PG8_ALIGN, PG8_SP2>(glds, g, S, E);
        }
        if (i < 3) SEAM(pb + 6);
    }
#undef IN
#undef SEAM
}

extern "C" void kernel_launch(void* const* d_in, const int* in_sizes, int n_in, void* d_out, int out_size, void* d_ws, size_t ws_size, hipStream_t stream) {
    static int grid = 0;
    if (grid == 0) {
        if (n_in != N_INPUTS || (size_t)out_size != O_END || ws_size < WS_END) { fprintf(stderr, "kernel_launch: unexpected shapes (n_in %d, out %d, ws %zu; need %d, %zu, >= %zu); nothing launched\n", n_in, out_size, ws_size, (int)N_INPUTS, (size_t)O_END, (size_t)WS_END); grid = -1; return; }
        int dev = 0, cus = 0, per_cu = 0;
        if (hipGetDevice(&dev) != hipSuccess || hipDeviceGetAttribute(&cus, hipDeviceAttributeMultiprocessorCount, dev) != hipSuccess) { grid = -1; return; }
        if (hipFuncSetAttribute((const void*)fwd_kernel, hipFuncAttributeMaxDynamicSharedMemorySize, LDS_BYTES) != hipSuccess) { fprintf(stderr, "kernel_launch: hipFuncSetAttribute failed\n"); grid = -1; return; }
        if (hipOccupancyMaxActiveBlocksPerMultiprocessor(&per_cu, (const void*)fwd_kernel, NWAVES * 64, LDS_BYTES) != hipSuccess || per_cu < 1) { fprintf(stderr, "kernel_launch: occupancy query says %d blocks per CU\n", per_cu); }
        (void)hipGetLastError();
        grid = cus;
    }
    if (grid < 0) return;
    (void)hipMemsetAsync((char*)d_ws + WS_CTL, 0, CTL_BYTES, stream);
    Args a{};
    for (int i = 0; i < N_INPUTS; ++i) a.in[i] = (const float*)d_in[i];
    a.out = (float*)d_out; a.ws = (unsigned char*)d_ws;
#if MK_N_LAUNCHES == 1
    a.ph_lo = 0; a.ph_hi = N_PHASES;
    hipLaunchKernelGGL(fwd_kernel, dim3(grid), dim3(NWAVES * 64), LDS_BYTES, stream, a);
#else
    for (int p = 0; p < N_PHASES; ++p) {
        if (p >= 1 && ((p - 1) % PH_PER_LAYER) == 2 && (((p - 1) / PH_PER_LAYER) & 1)) continue;
        a.ph_lo = p; a.ph_hi = p + 1;
        hipLaunchKernelGGL(fwd_kernel, dim3(grid), dim3(NWAVES * 64), LDS_BYTES, stream, a);
    }
#endif
}
```

```cpp
#include <hip/hip_runtime.h>
#include <stdio.h>
#include <stdint.h>

#ifndef MK_N_LAUNCHES
#define MK_N_LAUNCHES 1
#endif


constexpr int D = 2048, SEQ = 4096, NBP = 2, DSEQ = 64, NBS = 16, PAST = 1024;
constexpr int MP = NBP * SEQ, MS = NBS * DSEQ, M = MP + MS;
constexpr int N_IN_LRU = 5120, N_IN_ATT = 7168, K_OUT = 3072, N_UP = 11264, DFF = 5632, MEMW = 1024, MEMT = 256;
constexpr float EPS = 1e-6f;
constexpr float LOG2E = 1.4426950408889634f;
constexpr float QSCALE = 0.08838834764831845f * LOG2E;
constexpr float MQSCALE = 0.0625f * LOG2E;

enum { I_XP = 0, I_XS, I_MEM, I_CAK, I_CAV, I_CMK, I_CMV, I_SLH, I_SLC, I_SFC, I_NMIX, I_NFFN, I_LWIN, I_LCW, I_LCB, I_LGAW, I_LGAB, I_LGXW, I_LGXB,
       I_LLAM, I_LWOUT, I_AWIN, I_AQN, I_AKN, I_ALAM, I_ASUB, I_AWOUT, I_MNORM, I_MWKV, I_MQN, I_MKN, I_FUP, I_FCW, I_FCB, I_FDN, N_INPUTS };

constexpr size_t O_Y = 0;
constexpr size_t O_PLH = O_Y + (size_t)M * D;
constexpr size_t O_PLC = O_PLH + (size_t)2 * NBP * D;
constexpr size_t O_PAK = O_PLC + (size_t)2 * NBP * 3 * D;
constexpr size_t O_PAV = O_PAK + (size_t)2 * MP * D;
constexpr size_t O_PMK = O_PAV + (size_t)2 * MP * D;
constexpr size_t O_PMV = O_PMK + (size_t)4 * NBP * MEMT * MEMW;
constexpr size_t O_PFC = O_PMV + (size_t)4 * NBP * MEMT * MEMW;
constexpr size_t O_SLH = O_PFC + (size_t)4 * NBP * 2 * N_UP;
constexpr size_t O_SLC = O_SLH + (size_t)2 * NBS * D;
constexpr size_t O_SAK = O_SLC + (size_t)2 * NBS * 3 * D;
constexpr size_t O_SAV = O_SAK + (size_t)2 * MS * D;
constexpr size_t O_SFC = O_SAV + (size_t)2 * MS * D;
constexpr size_t O_END = O_SFC + (size_t)4 * NBS * 2 * N_UP;
static_assert(O_END == 100483072ull, "output size");

constexpr size_t MiB = 1ull << 20;
constexpr size_t WS_CTL = 0, CTL_BYTES = 64 * 1024;
constexpr size_t SZ_WINL = (size_t)N_IN_LRU * D * 2, SZ_WINA = (size_t)N_IN_ATT * D * 2, SZ_WOUT = (size_t)D * K_OUT * 2, SZ_WUP = (size_t)N_UP * D * 2, SZ_WDN = (size_t)D * DFF * 2;
constexpr size_t SZ_WKV = (size_t)4 * 2048 * D * 2, SZ_WG = (size_t)8 * 512 * 256 * 2;
constexpr size_t WS_WINL = 1 * MiB;
constexpr size_t WS_WINA = WS_WINL + 2 * SZ_WINL;
constexpr size_t WS_WOUT = WS_WINA + 2 * SZ_WINA;
constexpr size_t WS_WUP = WS_WOUT + 4 * SZ_WOUT;
constexpr size_t WS_WDN = WS_WUP + 4 * SZ_WUP;
constexpr size_t WS_WKV = WS_WDN + 4 * SZ_WDN;
constexpr size_t WS_WG = WS_WKV + SZ_WKV;
constexpr size_t WS_XB = WS_WG + 2 * SZ_WG;
constexpr size_t WS_MEMB = WS_XB + (size_t)M * D * 2;
constexpr size_t WS_SSA = WS_MEMB + (size_t)512 * D * 2;
constexpr size_t WS_SSB = WS_SSA + (size_t)M * 8 * 4;
constexpr size_t WS_MEMRS = WS_SSB + (size_t)M * 8 * 4;
constexpr size_t WS_CL8 = WS_MEMRS + 4096;
constexpr size_t WS_Z0 = WS_CL8 + (size_t)2 * 2048 * 4;
constexpr size_t WS_Z1 = WS_Z0 + (size_t)M * D * 2;
constexpr size_t WS_Z2 = WS_Z1 + (size_t)M * D * 2;
constexpr size_t WS_MQ = WS_Z2 + (size_t)M * D * 2;
constexpr size_t WS_HLOC = WS_MQ + (size_t)M * MEMW * 2;
constexpr size_t WS_PCUM = WS_HLOC + (size_t)M * D * 4;
constexpr size_t WS_AGGA = WS_PCUM + (size_t)M * D * 4;
constexpr size_t WS_AGGH = WS_AGGA + (size_t)144 * D * 4;
constexpr size_t WS_AOUT = WS_AGGH + (size_t)144 * D * 4;
constexpr size_t WS_UP = WS_AOUT + (size_t)M * K_OUT * 2;
constexpr size_t WS_ACT = WS_UP + (size_t)M * N_UP * 2;
constexpr size_t WS_MEMK = WS_ACT + (size_t)M * DFF * 2;
constexpr size_t WS_MEMV = WS_MEMK + (size_t)4 * 512 * MEMW * 2;
constexpr size_t WS_CAK = WS_MEMV + (size_t)4 * 512 * MEMW * 2;
constexpr size_t WS_CAV = WS_CAK + (size_t)2 * NBS * PAST * D * 2;
constexpr size_t WS_CMK = WS_CAV + (size_t)2 * NBS * PAST * D * 2;
constexpr size_t WS_CMV = WS_CMK + (size_t)4 * NBS * MEMT * MEMW * 2;
constexpr size_t WS_END = WS_CMV + (size_t)4 * NBS * MEMT * MEMW * 2;
static_assert(WS_WINA % 256 == 0 && WS_XB % 256 == 0 && WS_Z0 % 256 == 0 && WS_AOUT % 256 == 0 && WS_CAK % 256 == 0 && WS_END % 256 == 0, "ws alignment");

constexpr int CW_BAR = 4096;
constexpr int CW_QUEUE = 8192;

constexpr int LDS_EXCH = 131072;
constexpr int LDS_MISC = 131072 + 8192 + 1024;
constexpr int LDS_BYTES = LDS_MISC + 512;

#define GAS __attribute__((address_space(1)))
#define LAS __attribute__((address_space(3)))
typedef unsigned short bf16_t;
typedef short bf16x8 __attribute__((ext_vector_type(8)));
typedef short s16x4 __attribute__((ext_vector_type(4)));
typedef float f32x4 __attribute__((ext_vector_type(4)));
typedef float f32x2 __attribute__((ext_vector_type(2)));
typedef unsigned u32x4 __attribute__((ext_vector_type(4)));
typedef unsigned u32x2 __attribute__((ext_vector_type(2)));
#define LDS_WAIT() asm volatile("s_waitcnt lgkmcnt(0)" ::: "memory")
#define VM_WAIT() asm volatile("s_waitcnt vmcnt(0)" ::: "memory")

__device__ __forceinline__ unsigned f2bf(float f) { unsigned u = __builtin_bit_cast(unsigned, f); return (u + 0x7fffu + ((u >> 16) & 1u)) >> 16; }
__device__ __forceinline__ unsigned pk2(float lo, float hi) { return f2bf(lo) | (f2bf(hi) << 16); }
__device__ __forceinline__ float bf_lo(unsigned w) { return __builtin_bit_cast(float, w << 16); }
__device__ __forceinline__ float bf_hi(unsigned w) { return __builtin_bit_cast(float, w & 0xffff0000u); }
__device__ __forceinline__ float wave_sum(float v) {
#pragma unroll
    for (int o = 1; o < 64; o <<= 1) v += __shfl_xor(v, o);
    return v;
}
__device__ __forceinline__ float fexp2(float x) { return __builtin_amdgcn_exp2f(x); }
__device__ __forceinline__ float frcp(float x) { return __builtin_amdgcn_rcpf(x); }
__device__ __forceinline__ float sigmoidf_(float x) { return frcp(1.0f + fexp2(-x * LOG2E)); }
__device__ __forceinline__ float gelu_tanh(float x) { const float u = 0.7978845608028654f * (x + 0.044715f * x * x * x); return x * frcp(1.0f + fexp2(-2.0f * LOG2E * u)); }
namespace pg8 {
#define PG8_LAS __attribute__((address_space(3)))
typedef unsigned short bf16_t;
typedef short bf16x8 __attribute__((ext_vector_type(8)));
typedef float f32x4 __attribute__((ext_vector_type(4)));
typedef unsigned u32x4 __attribute__((ext_vector_type(4)));
constexpr int BM = 256, BK = 64, HALF = 128, HTB = HALF * BK * 2  , STAGE_BYTES = 8 * HTB, NXCD = 8, WGM = 8;

__host__ __device__ __forceinline__ int lds_byte(int r, int c) { const int st = (r >> 4) * 2 + (c >> 5), rr = r & 15, cc = c & 31, ob = rr * 64 + cc * 2; return st * 1024 + (ob ^ (((ob >> 9) & 1) << 5)); }
__host__ __device__ __forceinline__ void stage_rc(int b, int& R, int& C) { const int st = b / 1024, sb = b % 1024, swz = sb ^ (((sb >> 9) & 1) << 5); R = (st >> 1) * 16 + swz / 64; C = (st & 1) * 32 + (swz % 64) / 2; }
__host__ __device__ __forceinline__ int perm32(int rho) { const int n = rho >> 4, i = rho & 15; return 8 * (i >> 2) + 4 * n + (i & 3); }

struct Unit { int pm, pn; };
struct Gemm { const bf16_t* A; const bf16_t* Bt; int M, N, K; };

struct StaticOrder {
    int nM, nN, nwg, G, c;
    __host__ __device__ void init(int M, int N, int G_, int c_) { nM = M / BM; nN = N / BM; nwg = nM * nN; G = G_; c = c_; }
    __host__ __device__ bool next(int i, Unit& u) const {
        const long L = (long)i * G + c; if (L >= nwg) return false;
        int wgid = (int)L; { const int q = nwg / NXCD, r = nwg % NXCD, xcd = wgid % NXCD, off = wgid / NXCD; wgid = (xcd < r ? xcd * (q + 1) : r * (q + 1) + (xcd - r) * q) + off; }
        const int nig = WGM * nN, gid = wgid / nig, fm = gid * WGM, gsz = (nM - fm) < WGM ? (nM - fm) : WGM;
        u.pm = fm + ((wgid % nig) % gsz); u.pn = (wgid % nig) / gsz; return true;
    }
    __device__ __forceinline__ void a_ready(const Unit&) const {}
    __device__ __forceinline__ void done(const Unit&) const {}
};


__device__ __forceinline__ unsigned cvt_pk_bf16(float lo, float hi) { unsigned r; asm volatile("v_cvt_pk_bf16_f32 %0, %1, %2" : "=v"(r) : "v"(lo), "v"(hi)); return r; }
#define EPI_BAR() do { asm volatile("s_waitcnt lgkmcnt(0)" ::: "memory"); __builtin_amdgcn_s_barrier(); asm volatile("" ::: "memory"); } while (0)
#define OPAQUE(v) asm volatile("" : "+v"(v))
constexpr int EXCH_RSTD = 2048;

__device__ __forceinline__ void panel_rstd(const float* ss, int pm, PG8_LAS float* exch, float (&rs)[2][4], int rl0) {
    int tid = threadIdx.x; OPAQUE(tid);
    const f32x4 v = *(const f32x4*)((const char*)(ss + (size_t)pm * BM * 8) + (unsigned)tid * 16u);
    float s = (v[0] + v[1]) + (v[2] + v[3]); s += __shfl_xor(s, 1);
    if ((tid & 1) == 0) exch[EXCH_RSTD + (tid >> 1)] = __builtin_amdgcn_rsqf(s * (1.0f / 2048.0f) + 1e-6f);
    EPI_BAR();
#pragma unroll
    for (int ai = 0; ai < 2; ++ai)
#pragma unroll
        for (int m = 0; m < 4; ++m) rs[ai][m] = exch[EXCH_RSTD + rl0 + ai * HALF + m * 16];
}
__device__ __forceinline__ void st_bf16x8(char* p, const f32x4 v0, const f32x4 v1) {
    u32x4 w; w.x = cvt_pk_bf16(v0[0], v0[1]); w.y = cvt_pk_bf16(v0[2], v0[3]); w.z = cvt_pk_bf16(v1[0], v1[1]); w.w = cvt_pk_bf16(v1[2], v1[3]); *(u32x4*)p = w;
}
__device__ __forceinline__ void st_f32x8(char* p, const f32x4 v0, const f32x4 v1) { *(f32x4*)p = v0; *(f32x4*)(p + 16) = v1; }

__device__ __forceinline__ void norm256_store(const f32x4 (&acc)[2][2][4][2], const float (&rs)[2][4], const float* g, float osc, bf16_t* obf, unsigned ldb, float* of32, unsigned ldf,
                                              int rl0, int c0  , int wc, int fq, PG8_LAS float* exch) {
#pragma unroll
    for (int ai = 0; ai < 2; ++ai)
#pragma unroll
        for (int m = 0; m < 4; ++m) { float s = 0.f;
#pragma unroll
            for (int bj = 0; bj < 2; ++bj)
#pragma unroll
                for (int n = 0; n < 2; ++n) { const f32x4 x = acc[ai][bj][m][n]; s += (x[0] * x[0] + x[1] * x[1]) + (x[2] * x[2] + x[3] * x[3]); }
            s += __shfl_xor(s, 16); s += __shfl_xor(s, 32);
            if (fq == 0) exch[(rl0 + ai * HALF + m * 16) * 4 + wc] = s; }
    EPI_BAR();
    f32x4 gv[2][2];
#pragma unroll
    for (int bj = 0; bj < 2; ++bj)
#pragma unroll
        for (int n = 0; n < 2; ++n) gv[bj][n] = *(const f32x4*)((const char*)g + (unsigned)(c0 + bj * HALF + 4 * n) * 4u) * osc;
#pragma unroll
    for (int ai = 0; ai < 2; ++ai)
#pragma unroll
        for (int m = 0; m < 4; ++m) { const unsigned rl = rl0 + ai * HALF + m * 16; const f32x4 p = *(const PG8_LAS f32x4*)(exch + rl * 4);
            const float r = rs[ai][m]; const float tot = ((p[0] + p[1]) + (p[2] + p[3])) * r * r; const float rn = __builtin_amdgcn_rsqf(tot * (1.0f / 256.0f) + 1e-6f) * r;
#pragma unroll
            for (int bj = 0; bj < 2; ++bj) { const f32x4 v0 = acc[ai][bj][m][0] * rn * gv[bj][0], v1 = acc[ai][bj][m][1] * rn * gv[bj][1];
                st_bf16x8((char*)obf + (rl * ldb + c0 + bj * HALF) * 2u, v0, v1);
                if (of32) st_f32x8((char*)of32 + (rl * ldf + c0 + bj * HALF) * 4u, v0, v1); } }
}

struct EpiLruIn {
    static constexpr bool PERM = true, AFTER_DRAIN = false;
    const float* ss; bf16_t* gate; bf16_t* xr; bf16_t* mq; float* out; const float* gmq; PG8_LAS float* exch; int j;
    __device__ __forceinline__ void operator()(const f32x4 (&acc)[2][2][4][2], const Unit& u, int wr, int wc, int fr_, int fq_) const {
        int fr = fr_, fq = fq_; OPAQUE(fr); OPAQUE(fq);
        const int rl0 = wr * 64 + fr, c0 = wc * 32 + 8 * fq;
        float rs[2][4]; panel_rstd(ss, u.pm, exch, rs, rl0);
        if (u.pn < 16) {
            char* dst = (char*)((u.pn < 8) ? gate : xr) + ((size_t)u.pm * BM * D + (size_t)(u.pn & 7) * BM) * 2;
#pragma unroll
            for (int ai = 0; ai < 2; ++ai)
#pragma unroll
                for (int m = 0; m < 4; ++m) { const unsigned rl = rl0 + ai * HALF + m * 16; const int row = u.pm * BM + (int)rl; const float r = rs[ai][m];
                    float* so = nullptr;
                    if (u.pn >= 8) { if (row < MP) { const int b = row >> 12, t = row & 4095; if (t >= SEQ - 3) so = out + O_PLC + ((size_t)(j * NBP + b) * 3 + (t - (SEQ - 3))) * D + (size_t)(u.pn & 7) * BM; }
                                     else { const int r2 = row - MP, b = r2 >> 6, t = r2 & 63; if (t >= DSEQ - 3) so = out + O_SLC + ((size_t)(j * NBS + b) * 3 + (t - (DSEQ - 3))) * D + (size_t)(u.pn & 7) * BM; } }
#pragma unroll
                    for (int bj = 0; bj < 2; ++bj) { const f32x4 v0 = acc[ai][bj][m][0] * r, v1 = acc[ai][bj][m][1] * r;
                        st_bf16x8(dst + (rl * D + c0 + bj * HALF) * 2u, v0, v1);
                        if (so) st_f32x8((char*)(so + c0 + bj * HALF), v0, v1); } }
        } else {
            norm256_store(acc, rs, gmq, MQSCALE, mq + (size_t)u.pm * BM * MEMW + (size_t)(u.pn - 16) * 256, MEMW, nullptr, 0, rl0, c0, wc, fq, exch);
        }
    }
};

struct EpiAttIn {
    static constexpr bool PERM = true, AFTER_DRAIN = false;
    const float* ss; bf16_t* qb; bf16_t* kb; bf16_t* vb; bf16_t* mq; float* out; const float* gq; const float* gk; const float* gmq; PG8_LAS float* exch; int j;
    __device__ __forceinline__ void operator()(const f32x4 (&acc)[2][2][4][2], const Unit& u, int wr, int wc, int fr_, int fq_) const {
        int fr = fr_, fq = fq_; OPAQUE(fr); OPAQUE(fq);
        const int rl0 = wr * 64 + fr, c0 = wc * 32 + 8 * fq;
        float rs[2][4]; panel_rstd(ss, u.pm, exch, rs, rl0);
        const size_t orow = (u.pm < MP / BM) ? ((size_t)j * MP + (size_t)u.pm * BM) : ((size_t)j * MS + (size_t)(u.pm * BM - MP));
        if (u.pn < 16) {
            const bool isq = u.pn < 8; const float* g = isq ? gq : gk; const float osc = isq ? QSCALE : 1.0f;
#pragma unroll
            for (int ai = 0; ai < 2; ++ai)
#pragma unroll
                for (int m = 0; m < 4; ++m)
#pragma unroll
                    for (int bj = 0; bj < 2; ++bj) { const f32x4 x = acc[ai][bj][m][0], y = acc[ai][bj][m][1];
                        float s = ((x[0] * x[0] + x[1] * x[1]) + (x[2] * x[2] + x[3] * x[3])) + ((y[0] * y[0] + y[1] * y[1]) + (y[2] * y[2] + y[3] * y[3]));
                        s += __shfl_xor(s, 16); s += __shfl_xor(s, 32);
                        if (fq == 0) exch[((bj * 256) + rl0 + ai * HALF + m * 16) * 4 + wc] = s; }
            EPI_BAR();
            const f32x4 g0 = *(const f32x4*)((const char*)g + (unsigned)c0 * 4u) * osc, g1 = *(const f32x4*)((const char*)g + (unsigned)c0 * 4u + 16u) * osc;
            char* dst = (char*)(isq ? qb : kb) + ((size_t)u.pm * BM * D + (size_t)(u.pn & 7) * BM) * 2;
            char* fo = isq ? nullptr : (char*)(out + ((u.pm < MP / BM) ? O_PAK : O_SAK) + orow * D + (size_t)(u.pn & 7) * BM);
#pragma unroll
            for (int ai = 0; ai < 2; ++ai)
#pragma unroll
                for (int m = 0; m < 4; ++m) { const unsigned rl = rl0 + ai * HALF + m * 16; const float r = rs[ai][m];
#pragma unroll
                    for (int bj = 0; bj < 2; ++bj) { const f32x4 p = *(const PG8_LAS f32x4*)(exch + (bj * 256 + rl) * 4);
                        const float tot = ((p[0] + p[1]) + (p[2] + p[3])) * r * r; const float rn = __builtin_amdgcn_rsqf(tot * (1.0f / 128.0f) + 1e-6f) * r;
                        const f32x4 v0 = acc[ai][bj][m][0] * rn * g0, v1 = acc[ai][bj][m][1] * rn * g1;
                        st_bf16x8(dst + (rl * D + c0 + bj * HALF) * 2u, v0, v1);
                        if (fo) st_f32x8(fo + (rl * D + c0 + bj * HALF) * 4u, v0, v1); } }
        } else if (u.pn < 24) {
            char* dst = (char*)vb + ((size_t)u.pm * BM * D + (size_t)(u.pn - 16) * BM) * 2;
            char* fo = (char*)(out + ((u.pm < MP / BM) ? O_PAV : O_SAV) + orow * D + (size_t)(u.pn - 16) * BM);
#pragma unroll
            for (int ai = 0; ai < 2; ++ai)
#pragma unroll
                for (int m = 0; m < 4; ++m) { const unsigned rl = rl0 + ai * HALF + m * 16; const float r = rs[ai][m];
#pragma unroll
                    for (int bj = 0; bj < 2; ++bj) { const f32x4 v0 = acc[ai][bj][m][0] * r, v1 = acc[ai][bj][m][1] * r;
                        st_bf16x8(dst + (rl * D + c0 + bj * HALF) * 2u, v0, v1);
                        st_f32x8(fo + (rl * D + c0 + bj * HALF) * 4u, v0, v1); } }
        } else {
            norm256_store(acc, rs, gmq, MQSCALE, mq + (size_t)u.pm * BM * MEMW + (size_t)(u.pn - 24) * 256, MEMW, nullptr, 0, rl0, c0, wc, fq, exch);
        }
    }
};

struct EpiMemKV {
    static constexpr bool PERM = true, AFTER_DRAIN = false;
    const float* memrs; const float* gk  ; bf16_t* mk; bf16_t* mv; float* out; PG8_LAS float* exch;
    __device__ __forceinline__ void operator()(const f32x4 (&acc)[2][2][4][2], const Unit& u, int wr, int wc, int fr_, int fq_) const {
        int fr = fr_, fq = fq_; OPAQUE(fr); OPAQUE(fq);
        const int rl0 = wr * 64 + fr, c0 = wc * 32 + 8 * fq; const int i = u.pn >> 3, t = u.pn & 7;
        float rs[2][4];
#pragma unroll
        for (int ai = 0; ai < 2; ++ai)
#pragma unroll
            for (int m = 0; m < 4; ++m) rs[ai][m] = *(const float*)((const char*)(memrs + u.pm * BM) + (unsigned)(rl0 + ai * HALF + m * 16) * 4u);
        const size_t tbase = ((size_t)i * 512 + (size_t)u.pm * BM) * MEMW + (size_t)(t & 3) * 256;
        if (t < 4) {
            norm256_store(acc, rs, gk + i * 256, 1.0f, mk + tbase, MEMW, out + O_PMK + tbase, MEMW, rl0, c0, wc, fq, exch);
        } else {
            char* dst = (char*)(mv + tbase); char* fo = (char*)(out + O_PMV + tbase);
#pragma unroll
            for (int ai = 0; ai < 2; ++ai)
#pragma unroll
                for (int m = 0; m < 4; ++m) { const unsigned rl = rl0 + ai * HALF + m * 16; const float r = rs[ai][m];
#pragma unroll
                    for (int bj = 0; bj < 2; ++bj) { const f32x4 v0 = acc[ai][bj][m][0] * r, v1 = acc[ai][bj][m][1] * r;
                        st_bf16x8(dst + (rl * MEMW + c0 + bj * HALF) * 2u, v0, v1);
                        st_f32x8(fo + (rl * MEMW + c0 + bj * HALF) * 4u, v0, v1); } }
        }
    }
};

struct EpiResid {
    static constexpr bool PERM = false, AFTER_DRAIN = false;
    const float* base0; const float* base1;
    float* x; bf16_t* xb; float* ssout; PG8_LAS float* exch;
    __device__ __forceinline__ void operator()(const f32x4 (&acc)[2][2][4][2], const Unit& u, int wr, int wc, int fr_, int fq_) const {
        int fr = fr_, fq = fq_; OPAQUE(fr); OPAQUE(fq);
        const unsigned rl0 = wr * 64 + fr, col0 = u.pn * BM + wc * 32 + 4 * fq;
        const char* bp = (const char*)((u.pm < MP / BM) ? base0 + (size_t)u.pm * BM * D : base1 + (size_t)(u.pm * BM - MP) * D);
        char* xp = (char*)(x + (size_t)u.pm * BM * D); char* xbp = (char*)(xb + (size_t)u.pm * BM * D);
#pragma unroll
        for (int ai = 0; ai < 2; ++ai)
#pragma unroll
            for (int m = 0; m < 4; ++m) { const unsigned rl = rl0 + ai * HALF + m * 16; const unsigned o4 = (rl * D + col0) * 4u; float s = 0.f;
#pragma unroll
                for (int bj = 0; bj < 2; ++bj) {
                    const f32x4 b0 = *(const f32x4*)(bp + o4 + (bj * HALF) * 4u), b1 = *(const f32x4*)(bp + o4 + (bj * HALF + 16) * 4u);
                    const f32x4 v0 = b0 + acc[ai][bj][m][0], v1 = b1 + acc[ai][bj][m][1];
                    *(f32x4*)(xp + o4 + (bj * HALF) * 4u) = v0; *(f32x4*)(xp + o4 + (bj * HALF + 16) * 4u) = v1;
                    u32x2 w0, w1; w0.x = cvt_pk_bf16(v0[0], v0[1]); w0.y = cvt_pk_bf16(v0[2], v0[3]); w1.x = cvt_pk_bf16(v1[0], v1[1]); w1.y = cvt_pk_bf16(v1[2], v1[3]);
                    *(u32x2*)(xbp + (o4 >> 1) + (bj * HALF) * 2u) = w0; *(u32x2*)(xbp + (o4 >> 1) + (bj * HALF + 16) * 2u) = w1;
                    s += ((v0[0] * v0[0] + v0[1] * v0[1]) + (v0[2] * v0[2] + v0[3] * v0[3])) + ((v1[0] * v1[0] + v1[1] * v1[1]) + (v1[2] * v1[2] + v1[3] * v1[3])); }
                s += __shfl_xor(s, 16); s += __shfl_xor(s, 32);
                if (fq == 0) exch[rl * 4 + wc] = s;
                asm volatile("" ::: "memory"); }
        EPI_BAR();
        int tid = threadIdx.x; OPAQUE(tid);
        if (tid < 256) { const f32x4 p = *(const PG8_LAS f32x4*)(exch + tid * 4); *(float*)((char*)(ssout + (size_t)u.pm * BM * 8 + u.pn) + (unsigned)tid * 32u) = (p[0] + p[1]) + (p[2] + p[3]); }
    }
};

struct EpiUp {
    static constexpr bool PERM = true, AFTER_DRAIN = false;
    const float* ss; bf16_t* up; float* out; PG8_LAS float* exch; int i;
    __device__ __forceinline__ void operator()(const f32x4 (&acc)[2][2][4][2], const Unit& u, int wr, int wc, int fr_, int fq_) const {
        int fr = fr_, fq = fq_; OPAQUE(fr); OPAQUE(fq);
        const int rl0 = wr * 64 + fr, c0 = wc * 32 + 8 * fq;
        float rs[2][4]; panel_rstd(ss, u.pm, exch, rs, rl0);
        char* dst = (char*)up + ((size_t)u.pm * BM * N_UP + (size_t)u.pn * BM) * 2;
#pragma unroll
        for (int ai = 0; ai < 2; ++ai)
#pragma unroll
            for (int m = 0; m < 4; ++m) { const unsigned rl = rl0 + ai * HALF + m * 16; const int row = u.pm * BM + (int)rl; const float r = rs[ai][m];
                float* so = nullptr;
                if (row < MP) { const int b = row >> 12, t = row & 4095; if (t >= SEQ - 2) so = out + O_PFC + ((size_t)(i * NBP + b) * 2 + (t - (SEQ - 2))) * N_UP + (size_t)u.pn * BM; }
                else { const int r2 = row - MP, b = r2 >> 6, t = r2 & 63; if (t >= DSEQ - 2) so = out + O_SFC + ((size_t)(i * NBS + b) * 2 + (t - (DSEQ - 2))) * N_UP + (size_t)u.pn * BM; }
#pragma unroll
                for (int bj = 0; bj < 2; ++bj) { const f32x4 v0 = acc[ai][bj][m][0] * r, v1 = acc[ai][bj][m][1] * r;
                    st_bf16x8(dst + (rl * N_UP + c0 + bj * HALF) * 2u, v0, v1);
                    if (so) st_f32x8((char*)(so + c0 + bj * HALF), v0, v1); } }
    }
};
template <class Epi, class Sched, bool ALIGN_EPI = false, bool SP2 = false>
__device__ __forceinline__ void gemm_phase(PG8_LAS unsigned char* lds, const Gemm g, const Sched& S, const Epi& E) {
    int tid = threadIdx.x; asm volatile("" : "+v"(tid));
    const int wid = __builtin_amdgcn_readfirstlane(tid >> 6), lane = tid & 63, wr = wid >> 2, wc = wid & 3, fr = lane & 15, fq = lane >> 4;
    const int K = g.K, nt = K / BK;
    unsigned voffA[2], voffB[2];
#pragma unroll
    for (int i = 0; i < 2; ++i) { int R, C; stage_rc(tid * 16 + i * 8192, R, C); const int Rb = Epi::PERM ? ((R & ~31) + perm32(R & 31)) : R;
        voffA[i] = (unsigned)(R * K + C) * 2u; voffB[i] = (unsigned)(Rb * K + C) * 2u; }
    const size_t kstep = (size_t)(BK * 2);
    const size_t hstep = (size_t)HALF * K * 2;
    const size_t tstep = 2 * hstep;
    const unsigned ldsw = (unsigned)wid * 1024u;
    const int aoff = lds_byte(wr * 64 + fr, fq * 8), boff = lds_byte(wc * 32 + fr, fq * 8);
#define PG8_SA(b, h) (((b) * 2 + (h)) * HTB)
#define PG8_SB(b, h) ((4 + (b) * 2 + (h)) * HTB)
#define PG8_STAGE(bufoff, gbase, voff) do { _Pragma("unroll") for (int _i = 0; _i < 2; ++_i) \
        __builtin_amdgcn_global_load_lds((const unsigned*)((const char*)(gbase) + (voff)[_i]), (PG8_LAS unsigned*)(lds + (bufoff) + ldsw + _i * 8192), 16, 0, 0); } while (0)
#define PG8_LDA(dst, b, h) do { _Pragma("unroll") for (int m = 0; m < 4; ++m) _Pragma("unroll") for (int k = 0; k < 2; ++k) dst[m][k] = *(const PG8_LAS bf16x8*)(lds + PG8_SA(b, h) + aoff + m * 2048 + k * 1024); } while (0)
#define PG8_LDB(dst, b, h) do { _Pragma("unroll") for (int n = 0; n < 2; ++n) _Pragma("unroll") for (int k = 0; k < 2; ++k) dst[n][k] = *(const PG8_LAS bf16x8*)(lds + PG8_SB(b, h) + boff + n * 2048 + k * 1024); } while (0)
#define PG8_MMA(ai, bj, At, Bt) do { __builtin_amdgcn_s_setprio(1); _Pragma("unroll") for (int m = 0; m < 4; ++m) _Pragma("unroll") for (int n = 0; n < 2; ++n) _Pragma("unroll") for (int k = 0; k < 2; ++k) \
        acc[ai][bj][m][n] = __builtin_amdgcn_mfma_f32_16x16x32_bf16(Bt[n][k], At[m][k], acc[ai][bj][m][n], 0, 0, 0); __builtin_amdgcn_s_setprio(0); } while (0)
#define PG8_WAIT_V(n) asm volatile("s_waitcnt vmcnt(" #n ")" ::: "memory")
#define PG8_WAIT_L(n) asm volatile("s_waitcnt lgkmcnt(" #n ")" ::: "memory")
#define PG8_BAR __builtin_amdgcn_s_barrier()
#define PG8_SCHED __builtin_amdgcn_sched_barrier(0)
    Unit cur, nxt; int ui = 0;
    if (!S.next(0, cur)) return;
    f32x4 acc[2][2][4][2];
#pragma unroll
    for (int a = 0; a < 2; ++a)
#pragma unroll
        for (int b = 0; b < 2; ++b)
#pragma unroll
            for (int m = 0; m < 4; ++m)
#pragma unroll
                for (int n = 0; n < 2; ++n) acc[a][b][m][n] = (f32x4){0.f, 0.f, 0.f, 0.f};
    bf16x8 At[4][2], B0[2][2], B1[2][2];
    const char* cA = (const char*)g.A + (size_t)cur.pm * tstep; const char* cB = (const char*)g.Bt + (size_t)cur.pn * tstep;
    S.a_ready(cur);
    if constexpr (SP2) {
        PG8_STAGE(PG8_SB(0, 0), cB, voffB); PG8_STAGE(PG8_SB(0, 1), cB + hstep, voffB); PG8_STAGE(PG8_SA(0, 0), cA, voffA); PG8_STAGE(PG8_SA(0, 1), cA + hstep, voffA);
        if (wr == 1) PG8_BAR;
        PG8_WAIT_V(2); PG8_BAR;
        PG8_STAGE(PG8_SB(1, 0), cB + kstep, voffB); PG8_STAGE(PG8_SA(1, 0), cA + kstep, voffA); PG8_STAGE(PG8_SB(1, 1), cB + hstep + kstep, voffB);
        PG8_WAIT_V(6); PG8_BAR;
    } else {
        PG8_STAGE(PG8_SB(0, 0), cB, voffB); PG8_STAGE(PG8_SA(0, 0), cA, voffA); PG8_STAGE(PG8_SB(0, 1), cB + hstep, voffB); PG8_STAGE(PG8_SA(0, 1), cA + hstep, voffA);
        if (wr == 1) PG8_BAR;
        PG8_WAIT_V(4); PG8_BAR;
        PG8_STAGE(PG8_SB(1, 0), cB + kstep, voffB); PG8_STAGE(PG8_SA(1, 0), cA + kstep, voffA); PG8_STAGE(PG8_SB(1, 1), cB + hstep + kstep, voffB);
        PG8_WAIT_V(6); PG8_BAR;
    }
    for (;;) {
        const bool has_next = S.next(ui + 1, nxt);
        const char* nA = has_next ? (const char*)g.A + (size_t)nxt.pm * tstep : cA; const char* nB = has_next ? (const char*)g.Bt + (size_t)nxt.pn * tstep : cB;
        for (int t = 0; t < nt; t += 2) {
            const bool last = (t == nt - 2);
            const char* a1 = cA + (size_t)(t + 1) * kstep;
            const char* a2 = last ? nA : cA + (size_t)(t + 2) * kstep; const char* b2 = last ? nB : cB + (size_t)(t + 2) * kstep;
            const char* a3 = a2 + kstep; const char* b3 = b2 + kstep;
            if (last && has_next) S.a_ready(nxt);
            if constexpr (SP2) {
            PG8_LDB(B0, 0, 0); PG8_LDB(B1, 0, 1); PG8_SCHED; PG8_LDA(At, 0, 0); PG8_STAGE(PG8_SA(1, 1), a1 + hstep, voffA);
            PG8_WAIT_V(8); PG8_WAIT_L(0); PG8_BAR; PG8_MMA(0, 0, At, B0); PG8_MMA(0, 1, At, B1); PG8_BAR; PG8_SCHED;
            PG8_LDA(At, 0, 1); PG8_STAGE(PG8_SB(0, 0), b2, voffB); PG8_STAGE(PG8_SB(0, 1), b2 + hstep, voffB); PG8_STAGE(PG8_SA(0, 0), a2, voffA);
            PG8_WAIT_V(8); PG8_WAIT_L(0); PG8_BAR; PG8_MMA(1, 0, At, B0); PG8_MMA(1, 1, At, B1); PG8_BAR; PG8_SCHED;
            PG8_LDB(B0, 1, 0); PG8_LDB(B1, 1, 1); PG8_SCHED; PG8_LDA(At, 1, 0); PG8_STAGE(PG8_SA(0, 1), a2 + hstep, voffA);
            PG8_WAIT_V(8); PG8_WAIT_L(0); PG8_BAR; PG8_MMA(0, 0, At, B0); PG8_MMA(0, 1, At, B1); PG8_BAR; PG8_SCHED;
            PG8_LDA(At, 1, 1); PG8_STAGE(PG8_SB(1, 0), b3, voffB); PG8_STAGE(PG8_SB(1, 1), b3 + hstep, voffB); PG8_STAGE(PG8_SA(1, 0), a3, voffA);
            PG8_WAIT_V(8); PG8_WAIT_L(0); PG8_BAR; PG8_MMA(1, 0, At, B0); PG8_MMA(1, 1, At, B1); PG8_BAR; PG8_SCHED;
            } else {
            PG8_LDB(B0, 0, 0); PG8_SCHED; PG8_LDA(At, 0, 0); PG8_STAGE(PG8_SA(1, 1), a1 + hstep, voffA);
            PG8_WAIT_L(8); PG8_BAR; PG8_WAIT_L(0); PG8_MMA(0, 0, At, B0); PG8_BAR; PG8_SCHED;
            PG8_LDB(B1, 0, 1); PG8_STAGE(PG8_SB(0, 0), b2, voffB);
            PG8_BAR; PG8_WAIT_L(0); PG8_MMA(0, 1, At, B1); PG8_BAR;
            PG8_LDA(At, 0, 1); PG8_STAGE(PG8_SA(0, 0), a2, voffA);
            PG8_BAR; PG8_WAIT_L(0); PG8_MMA(1, 0, At, B0); PG8_BAR; PG8_SCHED;
            PG8_STAGE(PG8_SB(0, 1), b2 + hstep, voffB);
            PG8_WAIT_V(6); PG8_BAR; PG8_MMA(1, 1, At, B1); PG8_BAR;
            PG8_LDB(B0, 1, 0); PG8_SCHED; PG8_LDA(At, 1, 0); PG8_STAGE(PG8_SA(0, 1), a2 + hstep, voffA);
            PG8_WAIT_L(8); PG8_BAR; PG8_WAIT_L(0); PG8_MMA(0, 0, At, B0); PG8_BAR; PG8_SCHED;
            PG8_LDB(B1, 1, 1); PG8_STAGE(PG8_SB(1, 0), b3, voffB);
            PG8_BAR; PG8_WAIT_L(0); PG8_MMA(0, 1, At, B1); PG8_BAR;
            PG8_LDA(At, 1, 1); PG8_STAGE(PG8_SA(1, 0), a3, voffA);
            PG8_BAR; PG8_WAIT_L(0); PG8_MMA(1, 0, At, B0); PG8_BAR; PG8_SCHED;
            PG8_STAGE(PG8_SB(1, 1), b3 + hstep, voffB);
            PG8_WAIT_V(6); PG8_BAR; PG8_MMA(1, 1, At, B1); PG8_BAR;
            }
        }
        if constexpr (ALIGN_EPI) { if (wr == 0) PG8_BAR; }
        if constexpr (!Epi::AFTER_DRAIN) { E(acc, cur, wr, wc, fr, fq); S.done(cur); }
        if (!has_next) break;
#pragma unroll
        for (int a = 0; a < 2; ++a)
#pragma unroll
            for (int b = 0; b < 2; ++b)
#pragma unroll
                for (int m = 0; m < 4; ++m)
#pragma unroll
                    for (int n = 0; n < 2; ++n) acc[a][b][m][n] = (f32x4){0.f, 0.f, 0.f, 0.f};
        cur = nxt; cA = nA; cB = nB; ++ui;
        if constexpr (ALIGN_EPI) { if (wr == 1) PG8_BAR; }
    }
    PG8_WAIT_V(0);
    if constexpr (!ALIGN_EPI) { if (wr == 0) PG8_BAR; }
    PG8_BAR;
    if constexpr (Epi::AFTER_DRAIN) { E.fused(acc, cur, wr, wc, fr, fq, lds, wid, lane); S.done(cur); }
#undef PG8_SA
#undef PG8_SB
#undef PG8_STAGE
#undef PG8_LDA
#undef PG8_LDB
#undef PG8_MMA
#undef PG8_WAIT_V
#undef PG8_WAIT_L
#undef PG8_BAR
#undef PG8_SCHED
}
}
#define XB_TMO      128
#define XB_XCNT(j)  (256  + 64 * (j))
#define XB_XSUB(j)  (1280 + 64 * (j))
#define XB_XGEN(j)  (2304 + 64 * (j))
#define XB_TOP      3328
#define XB_TOPGEN   3392
#define XCD_BAR_WORDS 3456
#define XB_SPIN_CAP (1u << 18)

__device__ __forceinline__ unsigned xb_ld(unsigned* p)              { return __hip_atomic_load(p, __ATOMIC_RELAXED, __HIP_MEMORY_SCOPE_AGENT); }
__device__ __forceinline__ unsigned xb_add(unsigned* p, unsigned v) { return __hip_atomic_fetch_add(p, v, __ATOMIC_RELAXED, __HIP_MEMORY_SCOPE_AGENT); }
__device__ __forceinline__ unsigned xb_xcc_id() { return (unsigned)__builtin_amdgcn_s_getreg((3 << 11) | 20) & 0xFu; }
#define XB_SPIN(cond, bar) do { unsigned _sp = 0; while (cond) { __builtin_amdgcn_s_sleep(1); \
    if ((++_sp & 255u) == 0u) { if (xb_ld(&(bar)[XB_TMO])) break; if (_sp > XB_SPIN_CAP) { atomicAdd(&(bar)[XB_TMO], 1u); break; } } } } while (0)

struct XcdBarrier {
    unsigned* bar; unsigned x;
    volatile LAS unsigned* st;
};

__device__ __forceinline__ XcdBarrier xcd_barrier_post(unsigned* bar, volatile LAS unsigned* st) {
    XcdBarrier b; b.bar = bar; b.x = xb_xcc_id(); b.st = st;
    if (threadIdx.x == 0) (void)xb_add(&bar[XB_XCNT(b.x)], 1u);
    return b;
}
__device__ __forceinline__ void xcd_barrier_complete(unsigned* bar, unsigned x, unsigned& nloc, unsigned& nx) {
    const unsigned G = gridDim.x * gridDim.y * gridDim.z;
    unsigned sum, cnt, mine, sp = 0u;
    for (;;) {
        sum = 0u; cnt = 0u; mine = 0u;
#pragma unroll
        for (unsigned j = 0; j < 16; ++j) { const unsigned c = xb_ld(&bar[XB_XCNT(j)]); sum += c; cnt += (c > 0u) ? 1u : 0u; mine = (j == x) ? c : mine; }
        if (sum == G) break;
        __builtin_amdgcn_s_sleep(1);
        if ((++sp & 255u) == 0u) { if (xb_ld(&bar[XB_TMO])) break; if (sp > XB_SPIN_CAP) { atomicAdd(&bar[XB_TMO], 1u); break; } }
    }
    nloc = mine > 0u ? mine : 1u; nx = cnt > 0u ? cnt : 1u;
}

__device__ __forceinline__ void xcd_barrier(const XcdBarrier& b) {
    asm volatile("s_waitcnt vmcnt(0)" ::: "memory");
    __syncthreads();
    if (threadIdx.x == 0) {
        unsigned* bar = b.bar;
        __builtin_amdgcn_s_waitcnt(0);
        unsigned nloc = b.st[0], nx = b.st[1];
        if (nloc == 0u) { xcd_barrier_complete(bar, b.x, nloc, nx); b.st[0] = nloc; b.st[1] = nx; }
        const unsigned old = xb_add(&bar[XB_XSUB(b.x)], 1u);
        const unsigned gen = old / nloc;
        if (old + 1u == (gen + 1u) * nloc) {
            __builtin_amdgcn_fence(__ATOMIC_RELEASE, "agent");
            asm volatile("s_waitcnt vmcnt(0)" ::: "memory");
            const unsigned og = xb_add(&bar[XB_TOP], 1u);
            const unsigned tg = og / nx;
            if (og + 1u == (tg + 1u) * nx) xb_add(&bar[XB_TOPGEN], 1u);
            else XB_SPIN(xb_ld(&bar[XB_TOPGEN]) == tg, bar);
            __builtin_amdgcn_fence(__ATOMIC_ACQUIRE, "agent");
            xb_add(&bar[XB_XGEN(b.x)], 1u);
            asm volatile("s_waitcnt vmcnt(0)" ::: "memory");
        } else {
            XB_SPIN(xb_ld(&bar[XB_XGEN(b.x)]) == gen, bar);
            __builtin_amdgcn_fence(__ATOMIC_ACQUIRE, "agent");
            asm volatile("s_waitcnt vmcnt(0)" ::: "memory");
        }
    }
    __syncthreads();
}

struct Args { const float* in[N_INPUTS]; float* out; unsigned char* ws; int ph_lo, ph_hi; };
static_assert(sizeof(Args) == N_INPUTS * 8 + 8 + 8 + 8, "Args has no padding");

__device__ __forceinline__ unsigned long long ldptr(const LAS unsigned long long* t, int k) {
    const unsigned long long v = t[k]; const unsigned lo = __builtin_amdgcn_readfirstlane((unsigned)v), hi = __builtin_amdgcn_readfirstlane((unsigned)(v >> 32)); return ((unsigned long long)hi << 32) | lo; }
struct Frame {
    LAS unsigned char* lds; int tid, lane, wave, G, gw, ngw; long gtid, nthreads;
};

__device__ __forceinline__ void p0_transpose_item(const float* W, int K, int N, bf16_t* WT, const float* gain, LAS float* scr, int item, int lane) {
    const int nblk = N / 32, kb = item / nblk, nb = item % nblk, k0 = 64 * kb, n0 = 32 * nb;
#pragma unroll 8
    for (int i = 0; i < 32; ++i) { const int kk = 2 * i + (lane >> 5); float v = W[(size_t)(k0 + kk) * N + n0 + (lane & 31)]; if (gain) v *= gain[k0 + kk]; scr[kk * 33 + (lane & 31)] = v; }
    LDS_WAIT(); asm volatile("" ::: "memory");
    const int c = lane & 7;
#pragma unroll
    for (int j = 0; j < 4; ++j) { const int n = (lane >> 3) + 8 * j; const LAS float* s = scr + (8 * c) * 33 + n;
        u32x4 o; o.x = pk2(s[0 * 33], s[1 * 33]); o.y = pk2(s[2 * 33], s[3 * 33]); o.z = pk2(s[4 * 33], s[5 * 33]); o.w = pk2(s[6 * 33], s[7 * 33]);
        *(u32x4*)(WT + (size_t)(n0 + n) * K + k0 + 8 * c) = o; }
    LDS_WAIT(); asm volatile("" ::: "memory");
}
struct Mat { const float* W; int K, N; bf16_t* WT; const float* gain; };
__device__ __forceinline__ Mat get_mat(const Args& a, int id) {
    Mat m; unsigned char* ws = a.ws;
    if (id < 2)       { m.W = a.in[I_LWIN] + (size_t)id * D * N_IN_LRU; m.K = D; m.N = N_IN_LRU; m.WT = (bf16_t*)(ws + WS_WINL + id * SZ_WINL); m.gain = a.in[I_NMIX] + (2 * id) * D; }
    else if (id < 4)  { const int j = id - 2; m.W = a.in[I_AWIN] + (size_t)j * D * N_IN_ATT; m.K = D; m.N = N_IN_ATT; m.WT = (bf16_t*)(ws + WS_WINA + j * SZ_WINA); m.gain = a.in[I_NMIX] + (2 * j + 1) * D; }
    else if (id < 8)  { const int i = id - 4; m.W = ((i & 1) ? a.in[I_AWOUT] : a.in[I_LWOUT]) + (size_t)(i >> 1) * K_OUT * D; m.K = K_OUT; m.N = D; m.WT = (bf16_t*)(ws + WS_WOUT + i * SZ_WOUT); m.gain = nullptr; }
    else if (id < 12) { const int i = id - 8; m.W = a.in[I_FUP] + (size_t)i * D * N_UP; m.K = D; m.N = N_UP; m.WT = (bf16_t*)(ws + WS_WUP + i * SZ_WUP); m.gain = a.in[I_NFFN] + i * D; }
    else if (id < 16) { const int i = id - 12; m.W = a.in[I_FDN] + (size_t)i * DFF * D; m.K = DFF; m.N = D; m.WT = (bf16_t*)(ws + WS_WDN + i * SZ_WDN); m.gain = nullptr; }
    else if (id < 20) { const int i = id - 16; m.W = a.in[I_MWKV] + (size_t)i * D * 2048; m.K = D; m.N = 2048; m.WT = (bf16_t*)(ws + WS_WKV) + (size_t)i * 2048 * D; m.gain = a.in[I_MNORM] + i * D; }
    else { const int g = id - 20, j = g >> 4, h = (g >> 1) & 7, which = g & 1;
        m.W = (which ? a.in[I_LGXW] : a.in[I_LGAW]) + (size_t)(j * 8 + h) * 256 * 256; m.K = 256; m.N = 256; m.WT = (bf16_t*)(ws + WS_WG + j * SZ_WG) + ((size_t)h * 512 + which * 256) * 256; m.gain = nullptr; }
    return m;
}
constexpr int N_MATS = 52;

__device__ __forceinline__ void p0_prologue(const Args& a, const Frame& F) {
    unsigned char* ws = a.ws;
    LAS float* scr = (LAS float*)(F.lds + F.wave * 16384);
    int rot = 0;
    for (int id = 0; id < N_MATS; ++id) {
        const Mat m = get_mat(a, id); const int nitems = (m.K / 64) * (m.N / 32);
        int first = F.gw - rot; if (first < 0) first += F.ngw;
        for (int it = first; it < nitems; it += F.ngw) p0_transpose_item(m.W, m.K, m.N, m.WT, m.gain, scr, it, F.lane);
        rot = (rot + nitems) % F.ngw;
    }
    {
        bf16_t* xb = (bf16_t*)(ws + WS_XB); float* ssa = (float*)(ws + WS_SSA);
        for (int m = F.gw; m < M; m += F.ngw) {
            const float* src = (m < MP) ? a.in[I_XP] + (size_t)m * D : a.in[I_XS] + (size_t)(m - MP) * D;
            const f32x4* xr = (const f32x4*)src + F.lane; u32x2* o = (u32x2*)(xb + (size_t)m * D) + F.lane; float s = 0.f;
#pragma unroll
            for (int j = 0; j < 8; ++j) { const f32x4 v = xr[64 * j]; s += (v[0] * v[0] + v[1] * v[1]) + (v[2] * v[2] + v[3] * v[3]); u32x2 w; w.x = pk2(v[0], v[1]); w.y = pk2(v[2], v[3]); o[64 * j] = w; }
            s = wave_sum(s);
            if (F.lane < 8) ssa[(size_t)m * 8 + F.lane] = (F.lane == 0) ? s : 0.f;
        }
    }
    {
        bf16_t* mb = (bf16_t*)(ws + WS_MEMB); float* mrs = (float*)(ws + WS_MEMRS);
        for (int m = F.gw; m < 512; m += F.ngw) {
            const f32x4* xr = (const f32x4*)(a.in[I_MEM] + (size_t)m * D) + F.lane; u32x2* o = (u32x2*)(mb + (size_t)m * D) + F.lane; float s = 0.f;
#pragma unroll
            for (int j = 0; j < 8; ++j) { const f32x4 v = xr[64 * j]; s += (v[0] * v[0] + v[1] * v[1]) + (v[2] * v[2] + v[3] * v[3]); u32x2 w; w.x = pk2(v[0], v[1]); w.y = pk2(v[2], v[3]); o[64 * j] = w; }
            s = wave_sum(s);
            if (F.lane == 0) mrs[m] = 1.0f / sqrtf(s * (1.0f / 2048.0f) + EPS);
        }
    }
    {
        const size_t n4[4] = {(size_t)2 * NBS * PAST * D / 4, (size_t)2 * NBS * PAST * D / 4, (size_t)4 * NBS * MEMT * MEMW / 4, (size_t)4 * NBS * MEMT * MEMW / 4};
        const float* srcs[4] = {a.in[I_CAK], a.in[I_CAV], a.in[I_CMK], a.in[I_CMV]};
        unsigned char* dsts[4] = {ws + WS_CAK, ws + WS_CAV, ws + WS_CMK, ws + WS_CMV};
#pragma unroll
        for (int q = 0; q < 4; ++q) { const f32x4* s = (const f32x4*)srcs[q]; u32x2* d = (u32x2*)dsts[q];
            for (size_t i = (size_t)F.gtid; i < n4[q]; i += (size_t)F.nthreads) { const f32x4 v = s[i]; u32x2 w; w.x = pk2(v[0], v[1]); w.y = pk2(v[2], v[3]); d[i] = w; } }
    }
    {
        float* cl8 = (float*)(ws + WS_CL8);
        for (long i = F.gtid; i < 2 * 2048; i += F.nthreads) { const float L = a.in[I_LLAM][i]; cl8[i] = 8.0f * (fminf(L, 0.f) - log1pf(expf(-fabsf(L)))); }
    }
}

__device__ __forceinline__ void ffn_act_phase(const Args& a, const Frame& F, int i) {
    const bf16_t* up = (const bf16_t*)(a.ws + WS_UP); bf16_t* act = (bf16_t*)(a.ws + WS_ACT);
    const float* cw = a.in[I_FCW] + (size_t)i * 3 * N_UP; const float* cb = a.in[I_FCB] + (size_t)i * N_UP; const float* st = a.in[I_SFC] + (size_t)i * NBS * 2 * N_UP;
    constexpr int NCH = DFF / 8, NRG = M / 8;
    for (long item = F.gtid; item < (long)NRG * NCH; item += F.nthreads) {
        const int rgp = (int)(item / NCH), cc = (int)(item % NCH), c0 = cc * 8, row0 = rgp * 8;
        float wg[3][8], wu[3][8], bg[8], bu[8];
#pragma unroll
        for (int k = 0; k < 3; ++k)
#pragma unroll
            for (int h = 0; h < 2; ++h) { const f32x4 g4 = *(const f32x4*)(cw + (size_t)k * N_UP + c0 + 4 * h), u4 = *(const f32x4*)(cw + (size_t)k * N_UP + DFF + c0 + 4 * h);
#pragma unroll
                for (int e = 0; e < 4; ++e) { wg[k][4 * h + e] = g4[e]; wu[k][4 * h + e] = u4[e]; } }
#pragma unroll
        for (int h = 0; h < 2; ++h) { const f32x4 g4 = *(const f32x4*)(cb + c0 + 4 * h), u4 = *(const f32x4*)(cb + DFF + c0 + 4 * h);
#pragma unroll
            for (int e = 0; e < 4; ++e) { bg[4 * h + e] = g4[e]; bu[4 * h + e] = u4[e]; } }
        float g2[8], g1[8], u2[8], u1[8];
        int t0, b; bool sample;
        if (row0 < MP) { b = row0 >> 12; t0 = row0 & 4095; sample = false; } else { const int r2 = row0 - MP; b = r2 >> 6; t0 = r2 & 63; sample = true; }
        if (t0 == 0) {
            if (sample) {
#pragma unroll
                for (int h = 0; h < 2; ++h) { const float* s0 = st + ((size_t)b * 2 + 0) * N_UP, *s1 = st + ((size_t)b * 2 + 1) * N_UP;
                    const f32x4 a0 = *(const f32x4*)(s0 + c0 + 4 * h), a1 = *(const f32x4*)(s1 + c0 + 4 * h), b0 = *(const f32x4*)(s0 + DFF + c0 + 4 * h), b1 = *(const f32x4*)(s1 + DFF + c0 + 4 * h);
#pragma unroll
                    for (int e = 0; e < 4; ++e) { g2[4 * h + e] = a0[e]; g1[4 * h + e] = a1[e]; u2[4 * h + e] = b0[e]; u1[4 * h + e] = b1[e]; } }
            } else {
#pragma unroll
                for (int e = 0; e < 8; ++e) { g2[e] = 0.f; g1[e] = 0.f; u2[e] = 0.f; u1[e] = 0.f; }
            }
        } else {
            const u32x4 a0 = *(const u32x4*)(up + (size_t)(row0 - 2) * N_UP + c0), a1 = *(const u32x4*)(up + (size_t)(row0 - 1) * N_UP + c0);
            const u32x4 b0 = *(const u32x4*)(up + (size_t)(row0 - 2) * N_UP + DFF + c0), b1 = *(const u32x4*)(up + (size_t)(row0 - 1) * N_UP + DFF + c0);
#pragma unroll
            for (int e = 0; e < 4; ++e) { g2[2 * e] = bf_lo(a0[e]); g2[2 * e + 1] = bf_hi(a0[e]); g1[2 * e] = bf_lo(a1[e]); g1[2 * e + 1] = bf_hi(a1[e]);
                                          u2[2 * e] = bf_lo(b0[e]); u2[2 * e + 1] = bf_hi(b0[e]); u1[2 * e] = bf_lo(b1[e]); u1[2 * e + 1] = bf_hi(b1[e]); }
        }
#pragma unroll
        for (int r = 0; r < 8; ++r) {
            const u32x4 ga = *(const u32x4*)(up + (size_t)(row0 + r) * N_UP + c0), ua = *(const u32x4*)(up + (size_t)(row0 + r) * N_UP + DFF + c0);
            float gc[8], uc[8], o[8];
#pragma unroll
            for (int e = 0; e < 4; ++e) { gc[2 * e] = bf_lo(ga[e]); gc[2 * e + 1] = bf_hi(ga[e]); uc[2 * e] = bf_lo(ua[e]); uc[2 * e + 1] = bf_hi(ua[e]); }
#pragma unroll
            for (int e = 0; e < 8; ++e) { const float yg = bg[e] + wg[0][e] * g2[e] + wg[1][e] * g1[e] + wg[2][e] * gc[e], yu = bu[e] + wu[0][e] * u2[e] + wu[1][e] * u1[e] + wu[2][e] * uc[e];
                o[e] = gelu_tanh(yg) * yu; g2[e] = g1[e]; g1[e] = gc[e]; u2[e] = u1[e]; u1[e] = uc[e]; }
            u32x4 w; w.x = pk2(o[0], o[1]); w.y = pk2(o[2], o[3]); w.z = pk2(o[4], o[5]); w.w = pk2(o[6], o[7]);
            *(u32x4*)(act + (size_t)(row0 + r) * DFF + c0) = w;
        }
    }
}

__device__ __forceinline__ void lru_b_phase(const Args& a, const Frame& F, int j) {
    const float* hloc = (const float*)(a.ws + WS_HLOC); const float* pcum = (const float*)(a.ws + WS_PCUM);
    const float* agga = (const float*)(a.ws + WS_AGGA); const float* aggh = (const float*)(a.ws + WS_AGGH);
    const bf16_t* gate = (const bf16_t*)(a.ws + WS_Z0); bf16_t* aout = (bf16_t*)(a.ws + WS_AOUT);
    for (long item = F.gtid; item < 144L * 512; item += F.nthreads) {
        const int rt = (int)(item >> 9), ch = ((int)item & 511) * 4;
        f32x4 H; int b; float* so = nullptr;
        if (rt < 128) { b = rt >> 6; const int q = rt & 63; H = (f32x4){0.f, 0.f, 0.f, 0.f};
            for (int p = 0; p < q; ++p) { const f32x4 A = *(const f32x4*)(agga + (size_t)(b * 64 + p) * D + ch), Hh = *(const f32x4*)(aggh + (size_t)(b * 64 + p) * D + ch); H = A * H + Hh; }
            if (q == 63) so = a.out + O_PLH + (size_t)(j * NBP + b) * D + ch;
        } else { b = rt - 128; H = *(const f32x4*)(a.in[I_SLH] + (size_t)(j * NBS + b) * D + ch); so = a.out + O_SLH + (size_t)(j * NBS + b) * D + ch; }
        for (int r = 0; r < 64; ++r) { const size_t row = (size_t)rt * 64 + r;
            const f32x4 hl = *(const f32x4*)(hloc + row * D + ch), pc = *(const f32x4*)(pcum + row * D + ch); const u32x2 gt = *(const u32x2*)(gate + row * D + ch);
            const f32x4 hv = hl + pc * H;
            const float m0 = gelu_tanh(bf_lo(gt.x)) * hv[0], m1 = gelu_tanh(bf_hi(gt.x)) * hv[1], m2 = gelu_tanh(bf_lo(gt.y)) * hv[2], m3 = gelu_tanh(bf_hi(gt.y)) * hv[3];
            u32x2 w; w.x = pk2(m0, m1); w.y = pk2(m2, m3); *(u32x2*)(aout + row * K_OUT + ch) = w;
            if (r == 63 && so) *(f32x4*)so = hv; }
    }
}

#define WG_BAR() do { asm volatile("s_waitcnt lgkmcnt(0)" ::: "memory"); __builtin_amdgcn_s_barrier(); asm volatile("" ::: "memory"); } while (0)
constexpr int KSTR = 528, VSTR = 544;
constexpr int KT_BYTES = 64 * KSTR, VT_BYTES = 64 * VSTR, TILE_BYTES = KT_BYTES + VT_BYTES;
static_assert(2 * TILE_BYTES <= LDS_MISC, "attention LDS");
typedef short v4i16_t __attribute__((ext_vector_type(4)));
__device__ __forceinline__ f32x4 mfma16(bf16x8 a, bf16x8 b, f32x4 c) { return __builtin_amdgcn_mfma_f32_16x16x32_bf16(a, b, c, 0, 0, 0); }
__device__ __forceinline__ s16x4 vtr(const LAS unsigned char* p) { return __builtin_bit_cast(s16x4, __builtin_amdgcn_ds_read_tr16_b64_v4i16((LAS v4i16_t*)p)); }
__device__ __forceinline__ unsigned cvtpk(float lo, float hi) { unsigned r; asm volatile("v_cvt_pk_bf16_f32 %0, %1, %2" : "=v"(r) : "v"(lo), "v"(hi)); return r; }

struct AttnU {
    const bf16_t* Q; int ldq;
    const bf16_t* K0; const bf16_t* V0; int ld0; int nt0;
    const bf16_t* K1; const bf16_t* V1; int ld1;
    int nt, stagger, nqw;
    bf16_t* O; int ldo;
    float lam, osc; const float* gsub;
};
__device__ __forceinline__ void tile_load(const bf16_t* base, int ld, int tid, u32x4 (&r)[4]) {
#pragma unroll
    for (int i = 0; i < 4; ++i) { const int id = tid + 512 * i, row = id >> 5, cc = id & 31; r[i] = *(const u32x4*)(base + (size_t)row * ld + cc * 8); }
}
__device__ __forceinline__ void tile_commit(LAS unsigned char* dst, int stride, int tid, const u32x4 (&r)[4]) {
#pragma unroll
    for (int i = 0; i < 4; ++i) { const int id = tid + 512 * i, row = id >> 5, cc = id & 31; *(LAS u32x4*)(dst + row * stride + cc * 16) = r[i]; }
}
__device__ __forceinline__ void sm_update(float& m, float& l, const f32x4 (&s)[4]) {
    float tm = fmaxf(fmaxf(s[0][0], s[0][1]), fmaxf(s[0][2], s[0][3]));
#pragma unroll
    for (int k = 1; k < 4; ++k) tm = fmaxf(tm, fmaxf(fmaxf(s[k][0], s[k][1]), fmaxf(s[k][2], s[k][3])));
    const float mn = fmaxf(m, tm); float acc = 0.f;
#pragma unroll
    for (int k = 0; k < 4; ++k) acc += (fexp2(s[k][0] - mn) + fexp2(s[k][1] - mn)) + (fexp2(s[k][2] - mn) + fexp2(s[k][3] - mn));
    l = l * fexp2(m - mn) + acc; m = mn;
}
__device__ __forceinline__ void sm_combine(float& m, float& l) {
    float mo = fmaxf(m, __shfl_xor(m, 16)); mo = fmaxf(mo, __shfl_xor(mo, 32));
    float ls = l * fexp2(m - mo); ls += __shfl_xor(ls, 16); ls += __shfl_xor(ls, 32);
    m = mo; l = 1.0f / ls;
}

template <int MODE  >
__device__ __forceinline__ void attn_unit(LAS unsigned char* lds, const AttnU& u, int tid, int wid, int lane) {
    const int lq = lane & 15, g = lane >> 4;
    const bool active = wid < u.nqw;
    const int nvis = u.nt - ((u.stagger && wid < 4) ? 1 : 0);
    bf16x8 qf[8];
    { const bf16_t* qp = u.Q + (size_t)(16 * (active ? wid : 0) + lq) * u.ldq + 8 * g;
#pragma unroll
      for (int ks = 0; ks < 8; ++ks) qf[ks] = *(const bf16x8*)(qp + 32 * ks); }
    float m1 = -INFINITY, m2 = -INFINITY, l1 = 0.f, l2 = 0.f;
    {
        u32x4 kr[4];
        tile_load(u.nt0 > 0 ? u.K0 : u.K1, u.nt0 > 0 ? u.ld0 : u.ld1, tid, kr);
        tile_commit(lds, KSTR, tid, kr);
        WG_BAR();
        for (int kt = 0; kt < u.nt; ++kt) {
            const bool more = kt + 1 < u.nt;
            if (more) { const int k2 = kt + 1; if (k2 < u.nt0) tile_load(u.K0 + (size_t)k2 * 64 * u.ld0, u.ld0, tid, kr); else tile_load(u.K1 + (size_t)(k2 - u.nt0) * 64 * u.ld1, u.ld1, tid, kr); }
            if (active && kt < nvis) {
                const LAS unsigned char* kp = lds + (kt & 1) * TILE_BYTES + lq * KSTR + 16 * g;
                f32x4 s1[4], s2[4];
#pragma unroll
                for (int kb = 0; kb < 4; ++kb) { f32x4 x = {0.f, 0.f, 0.f, 0.f}, y = {0.f, 0.f, 0.f, 0.f};
#pragma unroll
                    for (int ks = 0; ks < 4; ++ks) { x = mfma16(*(const LAS bf16x8*)(kp + kb * 16 * KSTR + 64 * ks), qf[ks], x); y = mfma16(*(const LAS bf16x8*)(kp + kb * 16 * KSTR + 256 + 64 * ks), qf[4 + ks], y); }
                    s1[kb] = x; s2[kb] = y; }
                if (MODE == 0) { sm_update(m1, l1, s1); sm_update(m2, l2, s2); }
                else {
#pragma unroll
                    for (int kb = 0; kb < 4; ++kb) s1[kb] += s2[kb];
                    sm_update(m1, l1, s1); }
            }
            if (more) tile_commit(lds + ((kt + 1) & 1) * TILE_BYTES, KSTR, tid, kr);
            WG_BAR();
        }
    }
    float il1, il2 = 0.f;
    { float l = l1; sm_combine(m1, l); il1 = l; if (MODE == 0) { float q = l2; sm_combine(m2, q); il2 = q * u.lam; } }
    f32x4 o[16];
#pragma unroll
    for (int db = 0; db < 16; ++db) o[db] = (f32x4){0.f, 0.f, 0.f, 0.f};
    {
        u32x4 kr[4], vr[4];
        tile_load(u.nt0 > 0 ? u.K0 : u.K1, u.nt0 > 0 ? u.ld0 : u.ld1, tid, kr);
        tile_load(u.nt0 > 0 ? u.V0 : u.V1, u.nt0 > 0 ? u.ld0 : u.ld1, tid, vr);
        tile_commit(lds, KSTR, tid, kr); tile_commit(lds + KT_BYTES, VSTR, tid, vr);
        WG_BAR();
        const int qq = lq >> 2, p = lane & 3;
        for (int kt = 0; kt < u.nt; ++kt) {
            const bool more = kt + 1 < u.nt;
            if (more) { const int k2 = kt + 1;
                if (k2 < u.nt0) { tile_load(u.K0 + (size_t)k2 * 64 * u.ld0, u.ld0, tid, kr); tile_load(u.V0 + (size_t)k2 * 64 * u.ld0, u.ld0, tid, vr); }
                else { tile_load(u.K1 + (size_t)(k2 - u.nt0) * 64 * u.ld1, u.ld1, tid, kr); tile_load(u.V1 + (size_t)(k2 - u.nt0) * 64 * u.ld1, u.ld1, tid, vr); } }
            if (active && kt < nvis) {
                const LAS unsigned char* kp = lds + (kt & 1) * TILE_BYTES + lq * KSTR + 16 * g;
                const LAS unsigned char* vp = lds + (kt & 1) * TILE_BYTES + KT_BYTES + (4 * g + qq) * VSTR + 8 * p;
#pragma unroll
                for (int s2i = 0; s2i < 2; ++s2i) {
                    f32x4 w[2];
#pragma unroll
                    for (int kk = 0; kk < 2; ++kk) { const int kb = 2 * s2i + kk; f32x4 x = {0.f, 0.f, 0.f, 0.f}, y = {0.f, 0.f, 0.f, 0.f};
#pragma unroll
                        for (int ks = 0; ks < 4; ++ks) { x = mfma16(*(const LAS bf16x8*)(kp + kb * 16 * KSTR + 64 * ks), qf[ks], x); y = mfma16(*(const LAS bf16x8*)(kp + kb * 16 * KSTR + 256 + 64 * ks), qf[4 + ks], y); }
#pragma unroll
                        for (int e = 0; e < 4; ++e) w[kk][e] = (MODE == 0) ? fexp2(x[e] - m1) * il1 - fexp2(y[e] - m2) * il2 : fexp2(x[e] + y[e] - m1) * il1; }
                    u32x4 pw; pw.x = cvtpk(w[0][0], w[0][1]); pw.y = cvtpk(w[0][2], w[0][3]); pw.z = cvtpk(w[1][0], w[1][1]); pw.w = cvtpk(w[1][2], w[1][3]);
                    const bf16x8 pb = __builtin_bit_cast(bf16x8, pw);
#pragma unroll
                    for (int db = 0; db < 16; ++db) { const s16x4 lo = vtr(vp + s2i * 32 * VSTR + db * 32), hi = vtr(vp + (s2i * 32 + 16) * VSTR + db * 32);
                        const bf16x8 va = __builtin_shufflevector(lo, hi, 0, 1, 2, 3, 4, 5, 6, 7);
                        o[db] = mfma16(va, pb, o[db]); }
                }
            }
            if (more) { tile_commit(lds + ((kt + 1) & 1) * TILE_BYTES, KSTR, tid, kr); tile_commit(lds + ((kt + 1) & 1) * TILE_BYTES + KT_BYTES, VSTR, tid, vr); }
            WG_BAR();
        }
    }
    if (active) {
        bf16_t* op = u.O + (size_t)(16 * wid + lq) * u.ldo + 4 * g;
        if (MODE == 0) {
            float ss = 0.f;
#pragma unroll
            for (int db = 0; db < 16; ++db) ss += (o[db][0] * o[db][0] + o[db][1] * o[db][1]) + (o[db][2] * o[db][2] + o[db][3] * o[db][3]);
            ss += __shfl_xor(ss, 16); ss += __shfl_xor(ss, 32);
            const float rn = __builtin_amdgcn_rsqf(ss * (1.0f / 256.0f) + EPS) * u.osc;
#pragma unroll
            for (int db = 0; db < 16; ++db) { const f32x4 gv = *(const f32x4*)(u.gsub + 16 * db + 4 * g); const f32x4 v = o[db] * rn * gv;
                u32x2 wv; wv.x = cvtpk(v[0], v[1]); wv.y = cvtpk(v[2], v[3]); *(u32x2*)(op + 16 * db) = wv; }
        } else {
#pragma unroll
            for (int db = 0; db < 16; ++db) { u32x2 wv; wv.x = cvtpk(o[db][0], o[db][1]); wv.y = cvtpk(o[db][2], o[db][3]); *(u32x2*)(op + 16 * db) = wv; }
        }
    }
}

__device__ __forceinline__ void lru_a_unit(const Args& a, LAS unsigned char* lds, int j, int rt, int h, int tid, int wid, int lane) {
    LAS unsigned char* XC = lds;
    const bf16_t* xr = (const bf16_t*)(a.ws + WS_Z1);
    const int lq = lane & 15, g = lane >> 4;
    const int row0 = rt * 64; const bool sample = rt >= 128; const int b = sample ? rt - 128 : rt >> 6; const int pos0 = sample ? 0 : (rt & 63) * 64;
    {
        const int c8 = tid & 31, rg = tid >> 5, ch0 = h * 256 + c8 * 8;
        const float* cw = a.in[I_LCW] + (size_t)j * 4 * D + ch0; const float* cb = a.in[I_LCB] + (size_t)j * D + ch0;
        float w[4][8], bias[8], xv[7][8];
#pragma unroll
        for (int k = 0; k < 4; ++k)
#pragma unroll
            for (int hh = 0; hh < 2; ++hh) { const f32x4 t = *(const f32x4*)(cw + (size_t)k * D + 4 * hh);
#pragma unroll
                for (int e = 0; e < 4; ++e) w[k][4 * hh + e] = t[e]; }
#pragma unroll
        for (int hh = 0; hh < 2; ++hh) { const f32x4 t = *(const f32x4*)(cb + 4 * hh);
#pragma unroll
            for (int e = 0; e < 4; ++e) bias[4 * hh + e] = t[e]; }
#pragma unroll
        for (int d = 0; d < 7; ++d) { const int t = 4 * rg + d - 3;
            if (pos0 + t >= 0) { const u32x4 v = *(const u32x4*)(xr + (size_t)(row0 + t) * D + ch0);
#pragma unroll
                for (int e = 0; e < 4; ++e) { xv[d][2 * e] = bf_lo(v[e]); xv[d][2 * e + 1] = bf_hi(v[e]); } }
            else if (sample) { const float* s = a.in[I_SLC] + ((size_t)(j * NBS + b) * 3 + (3 + t)) * D + ch0; const f32x4 s0 = *(const f32x4*)s, s1 = *(const f32x4*)(s + 4);
#pragma unroll
                for (int e = 0; e < 4; ++e) { xv[d][e] = s0[e]; xv[d][4 + e] = s1[e]; } }
            else {
#pragma unroll
                for (int e = 0; e < 8; ++e) xv[d][e] = 0.f; } }
#pragma unroll
        for (int r = 0; r < 4; ++r) { float y[8];
#pragma unroll
            for (int e = 0; e < 8; ++e) y[e] = bias[e] + w[0][e] * xv[r][e] + w[1][e] * xv[r + 1][e] + w[2][e] * xv[r + 2][e] + w[3][e] * xv[r + 3][e];
            u32x4 pw; pw.x = pk2(y[0], y[1]); pw.y = pk2(y[2], y[3]); pw.z = pk2(y[4], y[5]); pw.w = pk2(y[6], y[7]);
            *(LAS u32x4*)(XC + (4 * rg + r) * KSTR + c8 * 16) = pw; }
    }
    WG_BAR();
    f32x4 ca[4][2], cx[4][2];
#pragma unroll
    for (int mb = 0; mb < 4; ++mb)
#pragma unroll
        for (int nb = 0; nb < 2; ++nb) { ca[mb][nb] = (f32x4){0.f, 0.f, 0.f, 0.f}; cx[mb][nb] = (f32x4){0.f, 0.f, 0.f, 0.f}; }
    {
        const bf16_t* wpa = (const bf16_t*)(a.ws + WS_WG + (size_t)j * SZ_WG) + (size_t)h * 512 * 256 + (size_t)(32 * wid + lq) * 256 + 8 * g;
        const LAS unsigned char* ap = XC + lq * KSTR + 16 * g;
#pragma unroll 2
        for (int ks = 0; ks < 8; ++ks) {
            bf16x8 af[4];
#pragma unroll
            for (int mb = 0; mb < 4; ++mb) af[mb] = *(const LAS bf16x8*)(ap + mb * 16 * KSTR + 64 * ks);
#pragma unroll
            for (int nb = 0; nb < 2; ++nb) { const bf16x8 ba = *(const bf16x8*)(wpa + nb * 16 * 256 + 32 * ks), bx = *(const bf16x8*)(wpa + 256 * 256 + nb * 16 * 256 + 32 * ks);
#pragma unroll
                for (int mb = 0; mb < 4; ++mb) { ca[mb][nb] = mfma16(af[mb], ba, ca[mb][nb]); cx[mb][nb] = mfma16(af[mb], bx, cx[mb][nb]); } }
        }
    }
    float* hloc = (float*)(a.ws + WS_HLOC); float* pcum = (float*)(a.ws + WS_PCUM);
#pragma unroll
    for (int nb = 0; nb < 2; ++nb) {
        const int c = 32 * wid + 16 * nb + lq, ch = h * 256 + c;
        const float ba_ = a.in[I_LGAB][(size_t)j * D + ch], bx_ = a.in[I_LGXB][(size_t)j * D + ch], cl = ((const float*)(a.ws + WS_CL8))[(size_t)j * D + ch] * LOG2E;
        float cA = 1.f, cH = 0.f;
#pragma unroll
        for (int mb = 0; mb < 4; ++mb) {
            float As[4], Hs[4]; float Al = 1.f, Hl = 0.f;
#pragma unroll
            for (int reg = 0; reg < 4; ++reg) { const int t = 16 * mb + 4 * g + reg;
                const float r = sigmoidf_(ca[mb][nb][reg] + ba_), ig = sigmoidf_(cx[mb][nb][reg] + bx_);
                const float av = fexp2(cl * r);
                const float xcv = __builtin_bit_cast(float, (unsigned)(*(const LAS unsigned short*)(XC + t * KSTR + c * 2)) << 16);
                const float gt = sqrtf(fmaxf(1.f - av * av, 0.f)) * (ig * xcv);
                Hl = av * Hl + gt; Al *= av; As[reg] = Al; Hs[reg] = Hl; }
            float Ak[4], Hk[4];
#pragma unroll
            for (int k = 0; k < 4; ++k) { Ak[k] = __shfl(Al, lq + 16 * k); Hk[k] = __shfl(Hl, lq + 16 * k); }
            float PA = cA, PH = cH;
#pragma unroll
            for (int k = 0; k < 3; ++k) if (k < g) { PH = Ak[k] * PH + Hk[k]; PA *= Ak[k]; }
#pragma unroll
            for (int reg = 0; reg < 4; ++reg) { const size_t o = (size_t)(row0 + 16 * mb + 4 * g + reg) * D + ch; hloc[o] = Hs[reg] + As[reg] * PH; pcum[o] = As[reg] * PA; }
#pragma unroll
            for (int k = 0; k < 4; ++k) { cH = Ak[k] * cH + Hk[k]; cA *= Ak[k]; }
        }
        if (g == 0) { ((float*)(a.ws + WS_AGGA))[(size_t)rt * D + ch] = cA; ((float*)(a.ws + WS_AGGH))[(size_t)rt * D + ch] = cH; }
    }
    WG_BAR();
}

template <bool ATT>
__device__ __forceinline__ void mixer_phase(const Args& a, const Frame& F, int i) {
    const int j = i >> 1;
    unsigned char* ws = a.ws;
    unsigned* queue = (unsigned*)(ws + WS_CTL) + CW_QUEUE + 64 * i;
    volatile LAS unsigned* misc = (volatile LAS unsigned*)(F.lds + LDS_MISC);
    const bf16_t* Z0 = (const bf16_t*)(ws + WS_Z0); const bf16_t* Z1 = (const bf16_t*)(ws + WS_Z1); const bf16_t* Z2 = (const bf16_t*)(ws + WS_Z2);
    const bf16_t* MQ = (const bf16_t*)(ws + WS_MQ); bf16_t* AO = (bf16_t*)(ws + WS_AOUT);
    float lam = 0.f, osc = 0.f;
    if (ATT) {
        const float* lp = a.in[I_ALAM] + (size_t)j * 4 * 128;
        float s1 = lp[F.lane] * lp[128 + F.lane] + lp[64 + F.lane] * lp[192 + F.lane], s2 = lp[256 + F.lane] * lp[384 + F.lane] + lp[320 + F.lane] * lp[448 + F.lane];
        s1 = wave_sum(s1); s2 = wave_sum(s2);
        const float lam_init = 0.8f - 0.6f * expf(-0.3f * (float)i);
        lam = expf(s1) - expf(s2) + lam_init; osc = 1.0f - lam_init;
    }
    constexpr int N_FIRST = ATT ? (NBS * 8 + 16 * 32) : (144 * 8);
    constexpr int N_TOTAL = N_FIRST + 256 + 64;
    for (;;) {
        if (F.tid == 0) misc[0] = __hip_atomic_fetch_add(queue, 1u, __ATOMIC_RELAXED, __HIP_MEMORY_SCOPE_AGENT);
        WG_BAR();
        const int idx = (int)misc[0];
        WG_BAR();
        if (idx >= N_TOTAL) break;
        if (idx < N_FIRST) {
            if (ATT) {
                AttnU u; u.ldq = D; u.ld0 = D; u.ld1 = D; u.ldo = K_OUT; u.lam = lam; u.osc = osc; u.gsub = a.in[I_ASUB] + (size_t)j * 256;
                if (idx < NBS * 8) { const int b = idx >> 3, h = idx & 7; const size_t r0 = (size_t)MP + b * DSEQ;
                    u.Q = Z0 + r0 * D + h * 256; u.K0 = (const bf16_t*)(ws + WS_CAK) + ((size_t)(j * NBS + b) * PAST) * D + h * 256; u.V0 = (const bf16_t*)(ws + WS_CAV) + ((size_t)(j * NBS + b) * PAST) * D + h * 256; u.nt0 = PAST / 64;
                    u.K1 = Z1 + r0 * D + h * 256; u.V1 = Z2 + r0 * D + h * 256; u.nt = PAST / 64 + 1; u.stagger = 0; u.nqw = 4; u.O = AO + r0 * K_OUT + h * 256;
                } else { const int k = idx - NBS * 8, qt = 31 - (k >> 4), bh = k & 15, b = bh >> 3, h = bh & 7; const size_t r0 = (size_t)b * SEQ + 128 * qt;
                    u.Q = Z0 + r0 * D + h * 256; u.K0 = nullptr; u.V0 = nullptr; u.nt0 = 0; u.K1 = Z1 + (size_t)b * SEQ * D + h * 256; u.V1 = Z2 + (size_t)b * SEQ * D + h * 256;
                    u.nt = 2 * qt + 2; u.stagger = 1; u.nqw = 8; u.O = AO + r0 * K_OUT + h * 256; }
                attn_unit<0>(F.lds, u, F.tid, F.wave, F.lane);
            } else {
                lru_a_unit(a, F.lds, j, idx >> 3, idx & 7, F.tid, F.wave, F.lane);
            }
        } else {
            AttnU u; u.ldq = MEMW; u.ld0 = MEMW; u.ld1 = MEMW; u.ldo = K_OUT; u.lam = 0.f; u.osc = 1.f; u.gsub = nullptr; u.stagger = 0; u.nt = 4;
            const int k = idx - N_FIRST;
            if (k < 256) { const int b = k >> 7, h = (k >> 5) & 3, qt = k & 31; const size_t r0 = (size_t)b * SEQ + 128 * qt;
                u.Q = MQ + r0 * MEMW + h * 256; u.K0 = nullptr; u.V0 = nullptr; u.nt0 = 0;
                u.K1 = (const bf16_t*)(ws + WS_MEMK) + ((size_t)i * 512 + b * MEMT) * MEMW + h * 256; u.V1 = (const bf16_t*)(ws + WS_MEMV) + ((size_t)i * 512 + b * MEMT) * MEMW + h * 256;
                u.nqw = 8; u.O = AO + r0 * K_OUT + 2048 + h * 256;
            } else { const int k2 = k - 256, b = k2 >> 2, h = k2 & 3; const size_t r0 = (size_t)MP + b * DSEQ;
                u.Q = MQ + r0 * MEMW + h * 256; u.K0 = (const bf16_t*)(ws + WS_CMK) + ((size_t)(i * NBS + b) * MEMT) * MEMW + h * 256; u.V0 = (const bf16_t*)(ws + WS_CMV) + ((size_t)(i * NBS + b) * MEMT) * MEMW + h * 256; u.nt0 = 4;
                u.K1 = u.K0; u.V1 = u.V0; u.nqw = 4; u.O = AO + r0 * K_OUT + 2048 + h * 256; }
            attn_unit<1>(F.lds, u, F.tid, F.wave, F.lane);
        }
    }
}

constexpr int NWAVES = 8;
#ifndef EN
#define EN 0xFFFF
#endif
constexpr int PH_PER_LAYER = 7, N_PHASES = 1 + 4 * PH_PER_LAYER;
#ifndef PG8_SP2
#define PG8_SP2 true
#endif
#ifndef PG8_ALIGN
#define PG8_ALIGN true
#endif

__global__ void __launch_bounds__(NWAVES * 64, 2) fwd_kernel(Args args) {
    extern __shared__ __attribute__((aligned(16))) unsigned char lds_raw[];
#define MAKE_FRAME() Frame F; { int t_ = threadIdx.x; asm volatile("" : "+v"(t_)); F.lds = (LAS unsigned char*)lds_raw; F.tid = t_; F.lane = t_ & 63; F.wave = __builtin_amdgcn_readfirstlane(t_ >> 6); \
        F.G = gridDim.x; F.gw = blockIdx.x * NWAVES + F.wave; F.ngw = F.G * NWAVES; F.gtid = (long)blockIdx.x * (NWAVES * 64) + t_; F.nthreads = (long)F.G * NWAVES * 64; }
    volatile LAS unsigned* MISC = (volatile LAS unsigned*)((LAS unsigned char*)lds_raw + LDS_MISC);
    LAS unsigned long long* ptab = (LAS unsigned long long*)((LAS unsigned char*)lds_raw + LDS_MISC + 128);
    if (threadIdx.x < 32) MISC[threadIdx.x] = 0u;
    if (threadIdx.x < N_INPUTS) ptab[threadIdx.x] = (unsigned long long)args.in[threadIdx.x];
    if (threadIdx.x == 64) { ptab[N_INPUTS] = (unsigned long long)args.out; ptab[N_INPUTS + 1] = (unsigned long long)args.ws; }
    __syncthreads();
#define LOAD_ARGS() Args a; { asm volatile("" ::: "memory"); _Pragma("unroll") for (int k_ = 0; k_ < N_INPUTS; ++k_) a.in[k_] = (const float*)(const GAS float*)ldptr(ptab, k_); \
        a.out = (float*)(GAS float*)ldptr(ptab, N_INPUTS); a.ws = (unsigned char*)(GAS unsigned char*)ldptr(ptab, N_INPUTS + 1); a.ph_lo = 0; a.ph_hi = 0; } unsigned char* const ws = a.ws; \
        const pg8::bf16_t* XB = (const pg8::bf16_t*)(ws + WS_XB); float* ssa = (float*)(ws + WS_SSA); float* ssb = (float*)(ws + WS_SSB); (void)XB; (void)ssa; (void)ssb
#if MK_N_LAUNCHES == 1
    constexpr int lo = 0, hi = N_PHASES;
#else
    const int lo = args.ph_lo, hi = args.ph_hi;
#endif
    XcdBarrier bar; bar.bar = (unsigned*)(args.ws + WS_CTL) + CW_BAR; bar.x = 0; bar.st = nullptr;
    if (hi - lo > 1) bar = xcd_barrier_post((unsigned*)(args.ws + WS_CTL) + CW_BAR, MISC + 8);
#define IN(k) (lo <= (k) && (k) < hi)
#define SEAM(k) do { if (IN(k) && IN((k) + 1)) { asm volatile("" ::: "memory"); XcdBarrier b2_; b2_.bar = (unsigned*)((unsigned char*)(GAS unsigned char*)ldptr(ptab, N_INPUTS + 1) + WS_CTL) + CW_BAR; b2_.x = bar.x; b2_.st = bar.st; xcd_barrier(b2_); } } while (0)
    PG8_LAS unsigned char* glds = (PG8_LAS unsigned char*)lds_raw;
    PG8_LAS float* exch = (PG8_LAS float*)(lds_raw + LDS_EXCH);

    if (IN(0) && (EN & 1)) { MAKE_FRAME(); LOAD_ARGS(); p0_prologue(a, F); }
    SEAM(0);

    for (int i = 0; i < 4; ++i) {
        const int pb = 1 + i * PH_PER_LAYER, j = i >> 1; const bool att = (i & 1) != 0;
        if (IN(pb) && (EN & 2)) {
            LOAD_ARGS();
            if (!att) {
                pg8::Gemm g{XB, (const pg8::bf16_t*)(ws + WS_WINL + j * SZ_WINL), M, N_IN_LRU, D}; pg8::StaticOrder S; S.init(M, N_IN_LRU, (int)gridDim.x, (int)blockIdx.x);
                pg8::EpiLruIn E{ssa, (bf16_t*)(ws + WS_Z0), (bf16_t*)(ws + WS_Z1), (bf16_t*)(ws + WS_MQ), a.out, a.in[I_MQN] + i * 256, exch, j};
                pg8::gemm_phase<pg8::EpiLruIn, pg8::StaticOrder, PG8_ALIGN, PG8_SP2>(glds, g, S, E);
                if (i == 0) {
                    pg8::Gemm g2{(const pg8::bf16_t*)(ws + WS_MEMB), (const pg8::bf16_t*)(ws + WS_WKV), 512, 8192, D}; pg8::StaticOrder S2; S2.init(512, 8192, (int)gridDim.x, (int)blockIdx.x);
                    pg8::EpiMemKV E2{(const float*)(ws + WS_MEMRS), a.in[I_MKN], (bf16_t*)(ws + WS_MEMK), (bf16_t*)(ws + WS_MEMV), a.out, exch};
                    pg8::gemm_phase<pg8::EpiMemKV, pg8::StaticOrder, PG8_ALIGN, PG8_SP2>(glds, g2, S2, E2);
                }
            } else {
                pg8::Gemm g{XB, (const pg8::bf16_t*)(ws + WS_WINA + j * SZ_WINA), M, N_IN_ATT, D}; pg8::StaticOrder S; S.init(M, N_IN_ATT, (int)gridDim.x, (int)blockIdx.x);
                pg8::EpiAttIn E{ssa, (bf16_t*)(ws + WS_Z0), (bf16_t*)(ws + WS_Z1), (bf16_t*)(ws + WS_Z2), (bf16_t*)(ws + WS_MQ), a.out,
                                a.in[I_AQN] + j * 128, a.in[I_AKN] + j * 128, a.in[I_MQN] + i * 256, exch, j};
                pg8::gemm_phase<pg8::EpiAttIn, pg8::StaticOrder, PG8_ALIGN, PG8_SP2>(glds, g, S, E);
            }
        }
        SEAM(pb);
        if (IN(pb + 1) && (EN & 4)) { MAKE_FRAME(); LOAD_ARGS(); if (att) { if (EN & 64) mixer_phase<true>(a, F, i); } else { if (EN & 128) mixer_phase<false>(a, F, i); } }
        SEAM(pb + 1);
        if (IN(pb + 2) && (EN & 8)) { MAKE_FRAME(); LOAD_ARGS(); if (!att) lru_b_phase(a, F, j); }
        if (!att) SEAM(pb + 2);
        if (IN(pb + 3) && (EN & 16)) {
            LOAD_ARGS();
            pg8::Gemm g{(const pg8::bf16_t*)(ws + WS_AOUT), (const pg8::bf16_t*)(ws + WS_WOUT + i * SZ_WOUT), M, D, K_OUT}; pg8::StaticOrder S; S.init(M, D, (int)gridDim.x, (int)blockIdx.x);
            const float* b0 = (i == 0) ? a.in[I_XP] : a.out + O_Y; const float* b1 = (i == 0) ? a.in[I_XS] : a.out + O_Y + (size_t)MP * D;
            pg8::EpiResid E{b0, b1, a.out + O_Y, (bf16_t*)(ws + WS_XB), ssb, exch};
            pg8::gemm_phase<pg8::EpiResid, pg8::StaticOrder, PG8_ALIGN, PG8_SP2>(glds, g, S, E);
        }
        SEAM(pb + 3);
        if (IN(pb + 4) && (EN & 32)) {
            LOAD_ARGS();
            pg8::Gemm g{XB, (const pg8::bf16_t*)(ws + WS_WUP + i * SZ_WUP), M, N_UP, D}; pg8::StaticOrder S; S.init(M, N_UP, (int)gridDim.x, (int)blockIdx.x);
            pg8::EpiUp E{ssb, (bf16_t*)(ws + WS_UP), a.out, exch, i};
            pg8::gemm_phase<pg8::EpiUp, pg8::StaticOrder, PG8_ALIGN, PG8_SP2>(glds, g, S, E);
        }
        SEAM(pb + 4);
        if (IN(pb + 5) && (EN & 256)) { MAKE_FRAME(); LOAD_ARGS(); ffn_act_phase(a, F, i); }
        SEAM(pb + 5);
        if (IN(pb + 6) && (EN & 512)) {
            LOAD_ARGS();
            pg8::Gemm g{(const pg8::bf16_t*)(ws + WS_ACT), (const pg8::bf16_t*)(ws + WS_WDN + i * SZ_WDN), M, D, DFF}; pg8::StaticOrder S; S.init(M, D, (int)gridDim.x, (int)blockIdx.x);
            pg8::EpiResid E{a.out + O_Y, a.out + O_Y + (size_t)MP * D, a.out + O_Y, (bf16_t*)(ws + WS_XB), ssa, exch};
            pg8::gemm_phase<pg8::EpiResid, pg8::StaticOrder, PG8_ALIGN, PG8_SP2>(glds, g, S, E);
        }
        if (i < 3) SEAM(pb + 6);
    }
#undef IN
#undef SEAM
}

extern "C" void kernel_launch(void* const* d_in, const int* in_sizes, int n_in, void* d_out, int out_size, void* d_ws, size_t ws_size, hipStream_t stream) {
    static int grid = 0;
    if (grid == 0) {
        if (n_in != N_INPUTS || (size_t)out_size != O_END || ws_size < WS_END) { fprintf(stderr, "kernel_launch: unexpected shapes (n_in %d, out %d, ws %zu; need %d, %zu, >= %zu); nothing launched\n", n_in, out_size, ws_size, (int)N_INPUTS, (size_t)O_END, (size_t)WS_END); grid = -1; return; }
        int dev = 0, cus = 0, per_cu = 0;
        if (hipGetDevice(&dev) != hipSuccess || hipDeviceGetAttribute(&cus, hipDeviceAttributeMultiprocessorCount, dev) != hipSuccess) { grid = -1; return; }
        if (hipFuncSetAttribute((const void*)fwd_kernel, hipFuncAttributeMaxDynamicSharedMemorySize, LDS_BYTES) != hipSuccess) { fprintf(stderr, "kernel_launch: hipFuncSetAttribute failed\n"); grid = -1; return; }
        if (hipOccupancyMaxActiveBlocksPerMultiprocessor(&per_cu, (const void*)fwd_kernel, NWAVES * 64, LDS_BYTES) != hipSuccess || per_cu < 1) { fprintf(stderr, "kernel_launch: occupancy query says %d blocks per CU\n", per_cu); }
        (void)hipGetLastError();
        grid = cus;
    }
    if (grid < 0) return;
    (void)hipMemsetAsync((char*)d_ws + WS_CTL, 0, CTL_BYTES, stream);
    Args a{};
    for (int i = 0; i < N_INPUTS; ++i) a.in[i] = (const float*)d_in[i];
    a.out = (float*)d_out; a.ws = (unsigned char*)d_ws;
#if MK_N_LAUNCHES == 1
    a.ph_lo = 0; a.ph_hi = N_PHASES;
    hipLaunchKernelGGL(fwd_kernel, dim3(grid), dim3(NWAVES * 64), LDS_BYTES, stream, a);
#else
    for (int p = 0; p < N_PHASES; ++p) {
        if (p >= 1 && ((p - 1) % PH_PER_LAYER) == 2 && (((p - 1) / PH_PER_LAYER) & 1)) continue;
        a.ph_lo = p; a.ph_hi = p + 1;
        hipLaunchKernelGGL(fwd_kernel, dim3(grid), dim3(NWAVES * 64), LDS_BYTES, stream, a);
    }
#endif
}
```

```cpp
#include <hip/hip_runtime.h>
#include <stdio.h>
#include <stdint.h>

#ifndef MK_N_LAUNCHES
#define MK_N_LAUNCHES 1
#endif


constexpr int D = 2048, SEQ = 4096, NBP = 2, DSEQ = 64, NBS = 16, PAST = 1024;
constexpr int MP = NBP * SEQ, MS = NBS * DSEQ, M = MP + MS;
constexpr int N_IN_LRU = 5120, N_IN_ATT = 7168, K_OUT = 3072, N_UP = 11264, DFF = 5632, MEMW = 1024, MEMT = 256;
constexpr float EPS = 1e-6f;
constexpr float LOG2E = 1.4426950408889634f;
constexpr float QSCALE = 0.08838834764831845f * LOG2E;
constexpr float MQSCALE = 0.0625f * LOG2E;

enum { I_XP = 0, I_XS, I_MEM, I_CAK, I_CAV, I_CMK, I_CMV, I_SLH, I_SLC, I_SFC, I_NMIX, I_NFFN, I_LWIN, I_LCW, I_LCB, I_LGAW, I_LGAB, I_LGXW, I_LGXB,
       I_LLAM, I_LWOUT, I_AWIN, I_AQN, I_AKN, I_ALAM, I_ASUB, I_AWOUT, I_MNORM, I_MWKV, I_MQN, I_MKN, I_FUP, I_FCW, I_FCB, I_FDN, N_INPUTS };

constexpr size_t O_Y = 0;
constexpr size_t O_PLH = O_Y + (size_t)M * D;
constexpr size_t O_PLC = O_PLH + (size_t)2 * NBP * D;
constexpr size_t O_PAK = O_PLC + (size_t)2 * NBP * 3 * D;
constexpr size_t O_PAV = O_PAK + (size_t)2 * MP * D;
constexpr size_t O_PMK = O_PAV + (size_t)2 * MP * D;
constexpr size_t O_PMV = O_PMK + (size_t)4 * NBP * MEMT * MEMW;
constexpr size_t O_PFC = O_PMV + (size_t)4 * NBP * MEMT * MEMW;
constexpr size_t O_SLH = O_PFC + (size_t)4 * NBP * 2 * N_UP;
constexpr size_t O_SLC = O_SLH + (size_t)2 * NBS * D;
constexpr size_t O_SAK = O_SLC + (size_t)2 * NBS * 3 * D;
constexpr size_t O_SAV = O_SAK + (size_t)2 * MS * D;
constexpr size_t O_SFC = O_SAV + (size_t)2 * MS * D;
constexpr size_t O_END = O_SFC + (size_t)4 * NBS * 2 * N_UP;
static_assert(O_END == 100483072ull, "output size");

constexpr size_t MiB = 1ull << 20;
constexpr size_t WS_CTL = 0, CTL_BYTES = 64 * 1024;
constexpr size_t SZ_WINL = (size_t)N_IN_LRU * D * 2, SZ_WINA = (size_t)N_IN_ATT * D * 2, SZ_WOUT = (size_t)D * K_OUT * 2, SZ_WUP = (size_t)N_UP * D * 2, SZ_WDN = (size_t)D * DFF * 2;
constexpr size_t SZ_WKV = (size_t)4 * 2048 * D * 2, SZ_WG = (size_t)8 * 512 * 256 * 2;
constexpr size_t WS_WINL = 1 * MiB;
constexpr size_t WS_WINA = WS_WINL + 2 * SZ_WINL;
constexpr size_t WS_WOUT = WS_WINA + 2 * SZ_WINA;
constexpr size_t WS_WUP = WS_WOUT + 4 * SZ_WOUT;
constexpr size_t WS_WDN = WS_WUP + 4 * SZ_WUP;
constexpr size_t WS_WKV = WS_WDN + 4 * SZ_WDN;
constexpr size_t WS_WG = WS_WKV + SZ_WKV;
constexpr size_t WS_XB = WS_WG + 2 * SZ_WG;
constexpr size_t WS_MEMB = WS_XB + (size_t)M * D * 2;
constexpr size_t WS_SSA = WS_MEMB + (size_t)512 * D * 2;
constexpr size_t WS_SSB = WS_SSA + (size_t)M * 8 * 4;
constexpr size_t WS_MEMRS = WS_SSB + (size_t)M * 8 * 4;
constexpr size_t WS_CL8 = WS_MEMRS + 4096;
constexpr size_t WS_Z0 = WS_CL8 + (size_t)2 * 2048 * 4;
constexpr size_t WS_Z1 = WS_Z0 + (size_t)M * D * 2;
constexpr size_t WS_Z2 = WS_Z1 + (size_t)M * D * 2;
constexpr size_t WS_MQ = WS_Z2 + (size_t)M * D * 2;
constexpr size_t WS_HLOC = WS_MQ + (size_t)M * MEMW * 2;
constexpr size_t WS_PCUM = WS_HLOC + (size_t)M * D * 4;
constexpr size_t WS_AGGA = WS_PCUM + (size_t)M * D * 4;
constexpr size_t WS_AGGH = WS_AGGA + (size_t)144 * D * 4;
constexpr size_t WS_AOUT = WS_AGGH + (size_t)144 * D * 4;
constexpr size_t WS_UP = WS_AOUT + (size_t)M * K_OUT * 2;
constexpr size_t WS_ACT = WS_UP + (size_t)M * N_UP * 2;
constexpr size_t WS_MEMK = WS_ACT + (size_t)M * DFF * 2;
constexpr size_t WS_MEMV = WS_MEMK + (size_t)4 * 512 * MEMW * 2;
constexpr size_t WS_CAK = WS_MEMV + (size_t)4 * 512 * MEMW * 2;
constexpr size_t WS_CAV = WS_CAK + (size_t)2 * NBS * PAST * D * 2;
constexpr size_t WS_CMK = WS_CAV + (size_t)2 * NBS * PAST * D * 2;
constexpr size_t WS_CMV = WS_CMK + (size_t)4 * NBS * MEMT * MEMW * 2;
constexpr size_t WS_END = WS_CMV + (size_t)4 * NBS * MEMT * MEMW * 2;
static_assert(WS_WINA % 256 == 0 && WS_XB % 256 == 0 && WS_Z0 % 256 == 0 && WS_AOUT % 256 == 0 && WS_CAK % 256 == 0 && WS_END % 256 == 0, "ws alignment");

constexpr int CW_BAR = 4096;
constexpr int CW_QUEUE = 8192;

constexpr int LDS_EXCH = 131072;
constexpr int LDS_MISC = 131072 + 8192 + 1024;
constexpr int LDS_BYTES = LDS_MISC + 512;

#define GAS __attribute__((address_space(1)))
#define LAS __attribute__((address_space(3)))
typedef unsigned short bf16_t;
typedef short bf16x8 __attribute__((ext_vector_type(8)));
typedef short s16x4 __attribute__((ext_vector_type(4)));
typedef float f32x4 __attribute__((ext_vector_type(4)));
typedef float f32x2 __attribute__((ext_vector_type(2)));
typedef unsigned u32x4 __attribute__((ext_vector_type(4)));
typedef unsigned u32x2 __attribute__((ext_vector_type(2)));
#define LDS_WAIT() asm volatile("s_waitcnt lgkmcnt(0)" ::: "memory")
#define VM_WAIT() asm volatile("s_waitcnt vmcnt(0)" ::: "memory")

__device__ __forceinline__ unsigned f2bf(float f) { unsigned u = __builtin_bit_cast(unsigned, f); return (u + 0x7fffu + ((u >> 16) & 1u)) >> 16; }
__device__ __forceinline__ unsigned pk2(float lo, float hi) { return f2bf(lo) | (f2bf(hi) << 16); }
__device__ __forceinline__ float bf_lo(unsigned w) { return __builtin_bit_cast(float, w << 16); }
__device__ __forceinline__ float bf_hi(unsigned w) { return __builtin_bit_cast(float, w & 0xffff0000u); }
__device__ __forceinline__ float wave_sum(float v) {
#pragma unroll
    for (int o = 1; o < 64; o <<= 1) v += __shfl_xor(v, o);
    return v;
}
__device__ __forceinline__ float fexp2(float x) { return __builtin_amdgcn_exp2f(x); }
__device__ __forceinline__ float frcp(float x) { return __builtin_amdgcn_rcpf(x); }
__device__ __forceinline__ float sigmoidf_(float x) { return frcp(1.0f + fexp2(-x * LOG2E)); }
__device__ __forceinline__ float gelu_tanh(float x) { const float u = 0.7978845608028654f * (x + 0.044715f * x * x * x); return x * frcp(1.0f + fexp2(-2.0f * LOG2E * u)); }
namespace pg8 {
#define PG8_LAS __attribute__((address_space(3)))
typedef unsigned short bf16_t;
typedef short bf16x8 __attribute__((ext_vector_type(8)));
typedef float f32x4 __attribute__((ext_vector_type(4)));
typedef unsigned u32x4 __attribute__((ext_vector_type(4)));
constexpr int BM = 256, BK = 64, HALF = 128, HTB = HALF * BK * 2  , STAGE_BYTES = 8 * HTB, NXCD = 8, WGM = 8;

__host__ __device__ __forceinline__ int lds_byte(int r, int c) { const int st = (r >> 4) * 2 + (c >> 5), rr = r & 15, cc = c & 31, ob = rr * 64 + cc * 2; return st * 1024 + (ob ^ (((ob >> 9) & 1) << 5)); }
__host__ __device__ __forceinline__ void stage_rc(int b, int& R, int& C) { const int st = b / 1024, sb = b % 1024, swz = sb ^ (((sb >> 9) & 1) << 5); R = (st >> 1) * 16 + swz / 64; C = (st & 1) * 32 + (swz % 64) / 2; }
__host__ __device__ __forceinline__ int perm32(int rho) { const int n = rho >> 4, i = rho & 15; return 8 * (i >> 2) + 4 * n + (i & 3); }

struct Unit { int pm, pn; };
struct Gemm { const bf16_t* A; const bf16_t* Bt; int M, N, K; };

struct StaticOrder {
    int nM, nN, nwg, G, c;
    __host__ __device__ void init(int M, int N, int G_, int c_) { nM = M / BM; nN = N / BM; nwg = nM * nN; G = G_; c = c_; }
    __host__ __device__ bool next(int i, Unit& u) const {
        const long L = (long)i * G + c; if (L >= nwg) return false;
        int wgid = (int)L; { const int q = nwg / NXCD, r = nwg % NXCD, xcd = wgid % NXCD, off = wgid / NXCD; wgid = (xcd < r ? xcd * (q + 1) : r * (q + 1) + (xcd - r) * q) + off; }
        const int nig = WGM * nN, gid = wgid / nig, fm = gid * WGM, gsz = (nM - fm) < WGM ? (nM - fm) : WGM;
        u.pm = fm + ((wgid % nig) % gsz); u.pn = (wgid % nig) / gsz; return true;
    }
    __device__ __forceinline__ void a_ready(const Unit&) const {}
    __device__ __forceinline__ void done(const Unit&) const {}
};


__device__ __forceinline__ unsigned cvt_pk_bf16(float lo, float hi) { unsigned r; asm volatile("v_cvt_pk_bf16_f32 %0, %1, %2" : "=v"(r) : "v"(lo), "v"(hi)); return r; }
#define EPI_BAR() do { asm volatile("s_waitcnt lgkmcnt(0)" ::: "memory"); __builtin_amdgcn_s_barrier(); asm volatile("" ::: "memory"); } while (0)
#define OPAQUE(v) asm volatile("" : "+v"(v))
constexpr int EXCH_RSTD = 2048;

__device__ __forceinline__ void panel_rstd(const float* ss, int pm, PG8_LAS float* exch, float (&rs)[2][4], int rl0) {
    int tid = threadIdx.x; OPAQUE(tid);
    const f32x4 v = *(const f32x4*)((const char*)(ss + (size_t)pm * BM * 8) + (unsigned)tid * 16u);
    float s = (v[0] + v[1]) + (v[2] + v[3]); s += __shfl_xor(s, 1);
    if ((tid & 1) == 0) exch[EXCH_RSTD + (tid >> 1)] = __builtin_amdgcn_rsqf(s * (1.0f / 2048.0f) + 1e-6f);
    EPI_BAR();
#pragma unroll
    for (int ai = 0; ai < 2; ++ai)
#pragma unroll
        for (int m = 0; m < 4; ++m) rs[ai][m] = exch[EXCH_RSTD + rl0 + ai * HALF + m * 16];
}
__device__ __forceinline__ void st_bf16x8(char* p, const f32x4 v0, const f32x4 v1) {
    u32x4 w; w.x = cvt_pk_bf16(v0[0], v0[1]); w.y = cvt_pk_bf16(v0[2], v0[3]); w.z = cvt_pk_bf16(v1[0], v1[1]); w.w = cvt_pk_bf16(v1[2], v1[3]); *(u32x4*)p = w;
}
__device__ __forceinline__ void st_f32x8(char* p, const f32x4 v0, const f32x4 v1) { *(f32x4*)p = v0; *(f32x4*)(p + 16) = v1; }

__device__ __forceinline__ void norm256_store(const f32x4 (&acc)[2][2][4][2], const float (&rs)[2][4], const float* g, float osc, bf16_t* obf, unsigned ldb, float* of32, unsigned ldf,
                                              int rl0, int c0  , int wc, int fq, PG8_LAS float* exch) {
#pragma unroll
    for (int ai = 0; ai < 2; ++ai)
#pragma unroll
        for (int m = 0; m < 4; ++m) { float s = 0.f;
#pragma unroll
            for (int bj = 0; bj < 2; ++bj)
#pragma unroll
                for (int n = 0; n < 2; ++n) { const f32x4 x = acc[ai][bj][m][n]; s += (x[0] * x[0] + x[1] * x[1]) + (x[2] * x[2] + x[3] * x[3]); }
            s += __shfl_xor(s, 16); s += __shfl_xor(s, 32);
            if (fq == 0) exch[(rl0 + ai * HALF + m * 16) * 4 + wc] = s; }
    EPI_BAR();
    f32x4 gv[2][2];
#pragma unroll
    for (int bj = 0; bj < 2; ++bj)
#pragma unroll
        for (int n = 0; n < 2; ++n) gv[bj][n] = *(const f32x4*)((const char*)g + (unsigned)(c0 + bj * HALF + 4 * n) * 4u) * osc;
#pragma unroll
    for (int ai = 0; ai < 2; ++ai)
#pragma unroll
        for (int m = 0; m < 4; ++m) { const unsigned rl = rl0 + ai * HALF + m * 16; const f32x4 p = *(const PG8_LAS f32x4*)(exch + rl * 4);
            const float r = rs[ai][m]; const float tot = ((p[0] + p[1]) + (p[2] + p[3])) * r * r; const float rn = __builtin_amdgcn_rsqf(tot * (1.0f / 256.0f) + 1e-6f) * r;
#pragma unroll
            for (int bj = 0; bj < 2; ++bj) { const f32x4 v0 = acc[ai][bj][m][0] * rn * gv[bj][0], v1 = acc[ai][bj][m][1] * rn * gv[bj][1];
                st_bf16x8((char*)obf + (rl * ldb + c0 + bj * HALF) * 2u, v0, v1);
                if (of32) st_f32x8((char*)of32 + (rl * ldf + c0 + bj * HALF) * 4u, v0, v1); } }
}

struct EpiLruIn {
    static constexpr bool PERM = true, AFTER_DRAIN = false;
    const float* ss; bf16_t* gate; bf16_t* xr; bf16_t* mq; float* out; const float* gmq; PG8_LAS float* exch; int j;
    __device__ __forceinline__ void operator()(const f32x4 (&acc)[2][2][4][2], const Unit& u, int wr, int wc, int fr_, int fq_) const {
        int fr = fr_, fq = fq_; OPAQUE(fr); OPAQUE(fq);
        const int rl0 = wr * 64 + fr, c0 = wc * 32 + 8 * fq;
        float rs[2][4]; panel_rstd(ss, u.pm, exch, rs, rl0);
        if (u.pn < 16) {
            char* dst = (char*)((u.pn < 8) ? gate : xr) + ((size_t)u.pm * BM * D + (size_t)(u.pn & 7) * BM) * 2;
#pragma unroll
            for (int ai = 0; ai < 2; ++ai)
#pragma unroll
                for (int m = 0; m < 4; ++m) { const unsigned rl = rl0 + ai * HALF + m * 16; const int row = u.pm * BM + (int)rl; const float r = rs[ai][m];
                    float* so = nullptr;
                    if (u.pn >= 8) { if (row < MP) { const int b = row >> 12, t = row & 4095; if (t >= SEQ - 3) so = out + O_PLC + ((size_t)(j * NBP + b) * 3 + (t - (SEQ - 3))) * D + (size_t)(u.pn & 7) * BM; }
                                     else { const int r2 = row - MP, b = r2 >> 6, t = r2 & 63; if (t >= DSEQ - 3) so = out + O_SLC + ((size_t)(j * NBS + b) * 3 + (t - (DSEQ - 3))) * D + (size_t)(u.pn & 7) * BM; } }
#pragma unroll
                    for (int bj = 0; bj < 2; ++bj) { const f32x4 v0 = acc[ai][bj][m][0] * r, v1 = acc[ai][bj][m][1] * r;
                        st_bf16x8(dst + (rl * D + c0 + bj * HALF) * 2u, v0, v1);
                        if (so) st_f32x8((char*)(so + c0 + bj * HALF), v0, v1); } }
        } else {
            norm256_store(acc, rs, gmq, MQSCALE, mq + (size_t)u.pm * BM * MEMW + (size_t)(u.pn - 16) * 256, MEMW, nullptr, 0, rl0, c0, wc, fq, exch);
        }
    }
};

struct EpiAttIn {
    static constexpr bool PERM = true, AFTER_DRAIN = false;
    const float* ss; bf16_t* qb; bf16_t* kb; bf16_t* vb; bf16_t* mq; float* out; const float* gq; const float* gk; const float* gmq; PG8_LAS float* exch; int j;
    __device__ __forceinline__ void operator()(const f32x4 (&acc)[2][2][4][2], const Unit& u, int wr, int wc, int fr_, int fq_) const {
        int fr = fr_, fq = fq_; OPAQUE(fr); OPAQUE(fq);
        const int rl0 = wr * 64 + fr, c0 = wc * 32 + 8 * fq;
        float rs[2][4]; panel_rstd(ss, u.pm, exch, rs, rl0);
        const size_t orow = (u.pm < MP / BM) ? ((size_t)j * MP + (size_t)u.pm * BM) : ((size_t)j * MS + (size_t)(u.pm * BM - MP));
        if (u.pn < 16) {
            const bool isq = u.pn < 8; const float* g = isq ? gq : gk; const float osc = isq ? QSCALE : 1.0f;
#pragma unroll
            for (int ai = 0; ai < 2; ++ai)
#pragma unroll
                for (int m = 0; m < 4; ++m)
#pragma unroll
                    for (int bj = 0; bj < 2; ++bj) { const f32x4 x = acc[ai][bj][m][0], y = acc[ai][bj][m][1];
                        float s = ((x[0] * x[0] + x[1] * x[1]) + (x[2] * x[2] + x[3] * x[3])) + ((y[0] * y[0] + y[1] * y[1]) + (y[2] * y[2] + y[3] * y[3]));
                        s += __shfl_xor(s, 16); s += __shfl_xor(s, 32);
                        if (fq == 0) exch[((bj * 256) + rl0 + ai * HALF + m * 16) * 4 + wc] = s; }
            EPI_BAR();
            const f32x4 g0 = *(const f32x4*)((const char*)g + (unsigned)c0 * 4u) * osc, g1 = *(const f32x4*)((const char*)g + (unsigned)c0 * 4u + 16u) * osc;
            char* dst = (char*)(isq ? qb : kb) + ((size_t)u.pm * BM * D + (size_t)(u.pn & 7) * BM) * 2;
            char* fo = isq ? nullptr : (char*)(out + ((u.pm < MP / BM) ? O_PAK : O_SAK) + orow * D + (size_t)(u.pn & 7) * BM);
#pragma unroll
            for (int ai = 0; ai < 2; ++ai)
#pragma unroll
                for (int m = 0; m < 4; ++m) { const unsigned rl = rl0 + ai * HALF + m * 16; const float r = rs[ai][m];
#pragma unroll
                    for (int bj = 0; bj < 2; ++bj) { const f32x4 p = *(const PG8_LAS f32x4*)(exch + (bj * 256 + rl) * 4);
                        const float tot = ((p[0] + p[1]) + (p[2] + p[3])) * r * r; const float rn = __builtin_amdgcn_rsqf(tot * (1.0f / 128.0f) + 1e-6f) * r;
                        const f32x4 v0 = acc[ai][bj][m][0] * rn * g0, v1 = acc[ai][bj][m][1] * rn * g1;
                        st_bf16x8(dst + (rl * D + c0 + bj * HALF) * 2u, v0, v1);
                        if (fo) st_f32x8(fo + (rl * D + c0 + bj * HALF) * 4u, v0, v1); } }
        } else if (u.pn < 24) {
            char* dst = (char*)vb + ((size_t)u.pm * BM * D + (size_t)(u.pn - 16) * BM) * 2;
            char* fo = (char*)(out + ((u.pm < MP / BM) ? O_PAV : O_SAV) + orow * D + (size_t)(u.pn - 16) * BM);
#pragma unroll
            for (int ai = 0; ai < 2; ++ai)
#pragma unroll
                for (int m = 0; m < 4; ++m) { const unsigned rl = rl0 + ai * HALF + m * 16; const float r = rs[ai][m];
#pragma unroll
                    for (int bj = 0; bj < 2; ++bj) { const f32x4 v0 = acc[ai][bj][m][0] * r, v1 = acc[ai][bj][m][1] * r;
                        st_bf16x8(dst + (rl * D + c0 + bj * HALF) * 2u, v0, v1);
                        st_f32x8(fo + (rl * D + c0 + bj * HALF) * 4u, v0, v1); } }
        } else {
            norm256_store(acc, rs, gmq, MQSCALE, mq + (size_t)u.pm * BM * MEMW + (size_t)(u.pn - 24) * 256, MEMW, nullptr, 0, rl0, c0, wc, fq, exch);
        }
    }
};

struct EpiMemKV {
    static constexpr bool PERM = true, AFTER_DRAIN = false;
    const float* memrs; const float* gk  ; bf16_t* mk; bf16_t* mv; float* out; PG8_LAS float* exch;
    __device__ __forceinline__ void operator()(const f32x4 (&acc)[2][2][4][2], const Unit& u, int wr, int wc, int fr_, int fq_) const {
        int fr = fr_, fq = fq_; OPAQUE(fr); OPAQUE(fq);
        const int rl0 = wr * 64 + fr, c0 = wc * 32 + 8 * fq; const int i = u.pn >> 3, t = u.pn & 7;
        float rs[2][4];
#pragma unroll
        for (int ai = 0; ai < 2; ++ai)
#pragma unroll
            for (int m = 0; m < 4; ++m) rs[ai][m] = *(const float*)((const char*)(memrs + u.pm * BM) + (unsigned)(rl0 + ai * HALF + m * 16) * 4u);
        const size_t tbase = ((size_t)i * 512 + (size_t)u.pm * BM) * MEMW + (size_t)(t & 3) * 256;
        if (t < 4) {
            norm256_store(acc, rs, gk + i * 256, 1.0f, mk + tbase, MEMW, out + O_PMK + tbase, MEMW, rl0, c0, wc, fq, exch);
        } else {
            char* dst = (char*)(mv + tbase); char* fo = (char*)(out + O_PMV + tbase);
#pragma unroll
            for (int ai = 0; ai < 2; ++ai)
#pragma unroll
                for (int m = 0; m < 4; ++m) { const unsigned rl = rl0 + ai * HALF + m * 16; const float r = rs[ai][m];
#pragma unroll
                    for (int bj = 0; bj < 2; ++bj) { const f32x4 v0 = acc[ai][bj][m][0] * r, v1 = acc[ai][bj][m][1] * r;
                        st_bf16x8(dst + (rl * MEMW + c0 + bj * HALF) * 2u, v0, v1);
                        st_f32x8(fo + (rl * MEMW + c0 + bj * HALF) * 4u, v0, v1); } }
        }
    }
};

struct EpiResid {
    static constexpr bool PERM = false, AFTER_DRAIN = false;
    const float* base0; const float* base1;
    float* x; bf16_t* xb; float* ssout; PG8_LAS float* exch;
    __device__ __forceinline__ void operator()(const f32x4 (&acc)[2][2][4][2], const Unit& u, int wr, int wc, int fr_, int fq_) const {
        int fr = fr_, fq = fq_; OPAQUE(fr); OPAQUE(fq);
        const unsigned rl0 = wr * 64 + fr, col0 = u.pn * BM + wc * 32 + 4 * fq;
        const char* bp = (const char*)((u.pm < MP / BM) ? base0 + (size_t)u.pm * BM * D : base1 + (size_t)(u.pm * BM - MP) * D);
        char* xp = (char*)(x + (size_t)u.pm * BM * D); char* xbp = (char*)(xb + (size_t)u.pm * BM * D);
#pragma unroll
        for (int ai = 0; ai < 2; ++ai)
#pragma unroll
            for (int m = 0; m < 4; ++m) { const unsigned rl = rl0 + ai * HALF + m * 16; const unsigned o4 = (rl * D + col0) * 4u; float s = 0.f;
#pragma unroll
                for (int bj = 0; bj < 2; ++bj) {
                    const f32x4 b0 = *(const f32x4*)(bp + o4 + (bj * HALF) * 4u), b1 = *(const f32x4*)(bp + o4 + (bj * HALF + 16) * 4u);
                    const f32x4 v0 = b0 + acc[ai][bj][m][0], v1 = b1 + acc[ai][bj][m][1];
                    *(f32x4*)(xp + o4 + (bj * HALF) * 4u) = v0; *(f32x4*)(xp + o4 + (bj * HALF + 16) * 4u) = v1;
                    u32x2 w0, w1; w0.x = cvt_pk_bf16(v0[0], v0[1]); w0.y = cvt_pk_bf16(v0[2], v0[3]); w1.x = cvt_pk_bf16(v1[0], v1[1]); w1.y = cvt_pk_bf16(v1[2], v1[3]);
                    *(u32x2*)(xbp + (o4 >> 1) + (bj * HALF) * 2u) = w0; *(u32x2*)(xbp + (o4 >> 1) + (bj * HALF + 16) * 2u) = w1;
                    s += ((v0[0] * v0[0] + v0[1] * v0[1]) + (v0[2] * v0[2] + v0[3] * v0[3])) + ((v1[0] * v1[0] + v1[1] * v1[1]) + (v1[2] * v1[2] + v1[3] * v1[3])); }
                s += __shfl_xor(s, 16); s += __shfl_xor(s, 32);
                if (fq == 0) exch[rl * 4 + wc] = s;
                asm volatile("" ::: "memory"); }
        EPI_BAR();
        int tid = threadIdx.x; OPAQUE(tid);
        if (tid < 256) { const f32x4 p = *(const PG8_LAS f32x4*)(exch + tid * 4); *(float*)((char*)(ssout + (size_t)u.pm * BM * 8 + u.pn) + (unsigned)tid * 32u) = (p[0] + p[1]) + (p[2] + p[3]); }
    }
};

struct EpiUp {
    static constexpr bool PERM = true, AFTER_DRAIN = false;
    const float* ss; bf16_t* up; float* out; PG8_LAS float* exch; int i;
    __device__ __forceinline__ void operator()(const f32x4 (&acc)[2][2][4][2], const Unit& u, int wr, int wc, int fr_, int fq_) const {
        int fr = fr_, fq = fq_; OPAQUE(fr); OPAQUE(fq);
        const int rl0 = wr * 64 + fr, c0 = wc * 32 + 8 * fq;
        float rs[2][4]; panel_rstd(ss, u.pm, exch, rs, rl0);
        char* dst = (char*)up + ((size_t)u.pm * BM * N_UP + (size_t)u.pn * BM) * 2;
#pragma unroll
        for (int ai = 0; ai < 2; ++ai)
#pragma unroll
            for (int m = 0; m < 4; ++m) { const unsigned rl = rl0 + ai * HALF + m * 16; const int row = u.pm * BM + (int)rl; const float r = rs[ai][m];
                float* so = nullptr;
                if (row < MP) { const int b = row >> 12, t = row & 4095; if (t >= SEQ - 2) so = out + O_PFC + ((size_t)(i * NBP + b) * 2 + (t - (SEQ - 2))) * N_UP + (size_t)u.pn * BM; }
                else { const int r2 = row - MP, b = r2 >> 6, t = r2 & 63; if (t >= DSEQ - 2) so = out + O_SFC + ((size_t)(i * NBS + b) * 2 + (t - (DSEQ - 2))) * N_UP + (size_t)u.pn * BM; }
#pragma unroll
                for (int bj = 0; bj < 2; ++bj) { const f32x4 v0 = acc[ai][bj][m][0] * r, v1 = acc[ai][bj][m][1] * r;
                    st_bf16x8(dst + (rl * N_UP + c0 + bj * HALF) * 2u, v0, v1);
                    if (so) st_f32x8((char*)(so + c0 + bj * HALF), v0, v1); } }
    }
};
template <class Epi, class Sched, bool ALIGN_EPI = false, bool SP2 = false>
__device__ __forceinline__ void gemm_phase(PG8_LAS unsigned char* lds, const Gemm g, const Sched& S, const Epi& E) {
    int tid = threadIdx.x; asm volatile("" : "+v"(tid));
    const int wid = __builtin_amdgcn_readfirstlane(tid >> 6), lane = tid & 63, wr = wid >> 2, wc = wid & 3, fr = lane & 15, fq = lane >> 4;
    const int K = g.K, nt = K / BK;
    unsigned voffA[2], voffB[2];
#pragma unroll
    for (int i = 0; i < 2; ++i) { int R, C; stage_rc(tid * 16 + i * 8192, R, C); const int Rb = Epi::PERM ? ((R & ~31) + perm32(R & 31)) : R;
        voffA[i] = (unsigned)(R * K + C) * 2u; voffB[i] = (unsigned)(Rb * K + C) * 2u; }
    const size_t kstep = (size_t)(BK * 2);
    const size_t hstep = (size_t)HALF * K * 2;
    const size_t tstep = 2 * hstep;
    const unsigned ldsw = (unsigned)wid * 1024u;
    const int aoff = lds_byte(wr * 64 + fr, fq * 8), boff = lds_byte(wc * 32 + fr, fq * 8);
#define PG8_SA(b, h) (((b) * 2 + (h)) * HTB)
#define PG8_SB(b, h) ((4 + (b) * 2 + (h)) * HTB)
#define PG8_STAGE(bufoff, gbase, voff) do { _Pragma("unroll") for (int _i = 0; _i < 2; ++_i) \
        __builtin_amdgcn_global_load_lds((const unsigned*)((const char*)(gbase) + (voff)[_i]), (PG8_LAS unsigned*)(lds + (bufoff) + ldsw + _i * 8192), 16, 0, 0); } while (0)
#define PG8_LDA(dst, b, h) do { _Pragma("unroll") for (int m = 0; m < 4; ++m) _Pragma("unroll") for (int k = 0; k < 2; ++k) dst[m][k] = *(const PG8_LAS bf16x8*)(lds + PG8_SA(b, h) + aoff + m * 2048 + k * 1024); } while (0)
#define PG8_LDB(dst, b, h) do { _Pragma("unroll") for (int n = 0; n < 2; ++n) _Pragma("unroll") for (int k = 0; k < 2; ++k) dst[n][k] = *(const PG8_LAS bf16x8*)(lds + PG8_SB(b, h) + boff + n * 2048 + k * 1024); } while (0)
#define PG8_MMA(ai, bj, At, Bt) do { __builtin_amdgcn_s_setprio(1); _Pragma("unroll") for (int m = 0; m < 4; ++m) _Pragma("unroll") for (int n = 0; n < 2; ++n) _Pragma("unroll") for (int k = 0; k < 2; ++k) \
        acc[ai][bj][m][n] = __builtin_amdgcn_mfma_f32_16x16x32_bf16(Bt[n][k], At[m][k], acc[ai][bj][m][n], 0, 0, 0); __builtin_amdgcn_s_setprio(0); } while (0)
#define PG8_WAIT_V(n) asm volatile("s_waitcnt vmcnt(" #n ")" ::: "memory")
#define PG8_WAIT_L(n) asm volatile("s_waitcnt lgkmcnt(" #n ")" ::: "memory")
#define PG8_BAR __builtin_amdgcn_s_barrier()
#define PG8_SCHED __builtin_amdgcn_sched_barrier(0)
    Unit cur, nxt; int ui = 0;
    if (!S.next(0, cur)) return;
    f32x4 acc[2][2][4][2];
#pragma unroll
    for (int a = 0; a < 2; ++a)
#pragma unroll
        for (int b = 0; b < 2; ++b)
#pragma unroll
            for (int m = 0; m < 4; ++m)
#pragma unroll
                for (int n = 0; n < 2; ++n) acc[a][b][m][n] = (f32x4){0.f, 0.f, 0.f, 0.f};
    bf16x8 At[4][2], B0[2][2], B1[2][2];
    const char* cA = (const char*)g.A + (size_t)cur.pm * tstep; const char* cB = (const char*)g.Bt + (size_t)cur.pn * tstep;
    S.a_ready(cur);
    if constexpr (SP2) {
        PG8_STAGE(PG8_SB(0, 0), cB, voffB); PG8_STAGE(PG8_SB(0, 1), cB + hstep, voffB); PG8_STAGE(PG8_SA(0, 0), cA, voffA); PG8_STAGE(PG8_SA(0, 1), cA + hstep, voffA);
        if (wr == 1) PG8_BAR;
        PG8_WAIT_V(2); PG8_BAR;
        PG8_STAGE(PG8_SB(1, 0), cB + kstep, voffB); PG8_STAGE(PG8_SA(1, 0), cA + kstep, voffA); PG8_STAGE(PG8_SB(1, 1), cB + hstep + kstep, voffB);
        PG8_WAIT_V(6); PG8_BAR;
    } else {
        PG8_STAGE(PG8_SB(0, 0), cB, voffB); PG8_STAGE(PG8_SA(0, 0), cA, voffA); PG8_STAGE(PG8_SB(0, 1), cB + hstep, voffB); PG8_STAGE(PG8_SA(0, 1), cA + hstep, voffA);
        if (wr == 1) PG8_BAR;
        PG8_WAIT_V(4); PG8_BAR;
        PG8_STAGE(PG8_SB(1, 0), cB + kstep, voffB); PG8_STAGE(PG8_SA(1, 0), cA + kstep, voffA); PG8_STAGE(PG8_SB(1, 1), cB + hstep + kstep, voffB);
        PG8_WAIT_V(6); PG8_BAR;
    }
    for (;;) {
        const bool has_next = S.next(ui + 1, nxt);
        const char* nA = has_next ? (const char*)g.A + (size_t)nxt.pm * tstep : cA; const char* nB = has_next ? (const char*)g.Bt + (size_t)nxt.pn * tstep : cB;
        for (int t = 0; t < nt; t += 2) {
            const bool last = (t == nt - 2);
            const char* a1 = cA + (size_t)(t + 1) * kstep;
            const char* a2 = last ? nA : cA + (size_t)(t + 2) * kstep; const char* b2 = last ? nB : cB + (size_t)(t + 2) * kstep;
            const char* a3 = a2 + kstep; const char* b3 = b2 + kstep;
            if (last && has_next) S.a_ready(nxt);
            if constexpr (SP2) {
            PG8_LDB(B0, 0, 0); PG8_LDB(B1, 0, 1); PG8_SCHED; PG8_LDA(At, 0, 0); PG8_STAGE(PG8_SA(1, 1), a1 + hstep, voffA);
            PG8_WAIT_V(8); PG8_WAIT_L(0); PG8_BAR; PG8_MMA(0, 0, At, B0); PG8_MMA(0, 1, At, B1); PG8_BAR; PG8_SCHED;
            PG8_LDA(At, 0, 1); PG8_STAGE(PG8_SB(0, 0), b2, voffB); PG8_STAGE(PG8_SB(0, 1), b2 + hstep, voffB); PG8_STAGE(PG8_SA(0, 0), a2, voffA);
            PG8_WAIT_V(8); PG8_WAIT_L(0); PG8_BAR; PG8_MMA(1, 0, At, B0); PG8_MMA(1, 1, At, B1); PG8_BAR; PG8_SCHED;
            PG8_LDB(B0, 1, 0); PG8_LDB(B1, 1, 1); PG8_SCHED; PG8_LDA(At, 1, 0); PG8_STAGE(PG8_SA(0, 1), a2 + hstep, voffA);
            PG8_WAIT_V(8); PG8_WAIT_L(0); PG8_BAR; PG8_MMA(0, 0, At, B0); PG8_MMA(0, 1, At, B1); PG8_BAR; PG8_SCHED;
            PG8_LDA(At, 1, 1); PG8_STAGE(PG8_SB(1, 0), b3, voffB); PG8_STAGE(PG8_SB(1, 1), b3 + hstep, voffB); PG8_STAGE(PG8_SA(1, 0), a3, voffA);
            PG8_WAIT_V(8); PG8_WAIT_L(0); PG8_BAR; PG8_MMA(1, 0, At, B0); PG8_MMA(1, 1, At, B1); PG8_BAR; PG8_SCHED;
            } else {
            PG8_LDB(B0, 0, 0); PG8_SCHED; PG8_LDA(At, 0, 0); PG8_STAGE(PG8_SA(1, 1), a1 + hstep, voffA);
            PG8_WAIT_L(8); PG8_BAR; PG8_WAIT_L(0); PG8_MMA(0, 0, At, B0); PG8_BAR; PG8_SCHED;
            PG8_LDB(B1, 0, 1); PG8_STAGE(PG8_SB(0, 0), b2, voffB);
            PG8_BAR; PG8_WAIT_L(0); PG8_MMA(0, 1, At, B1); PG8_BAR;
            PG8_LDA(At, 0, 1); PG8_STAGE(PG8_SA(0, 0), a2, voffA);
            PG8_BAR; PG8_WAIT_L(0); PG8_MMA(1, 0, At, B0); PG8_BAR; PG8_SCHED;
            PG8_STAGE(PG8_SB(0, 1), b2 + hstep, voffB);
            PG8_WAIT_V(6); PG8_BAR; PG8_MMA(1, 1, At, B1); PG8_BAR;
            PG8_LDB(B0, 1, 0); PG8_SCHED; PG8_LDA(At, 1, 0); PG8_STAGE(PG8_SA(0, 1), a2 + hstep, voffA);
            PG8_WAIT_L(8); PG8_BAR; PG8_WAIT_L(0); PG8_MMA(0, 0, At, B0); PG8_BAR; PG8_SCHED;
            PG8_LDB(B1, 1, 1); PG8_STAGE(PG8_SB(1, 0), b3, voffB);
            PG8_BAR; PG8_WAIT_L(0); PG8_MMA(0, 1, At, B1); PG8_BAR;
            PG8_LDA(At, 1, 1); PG8_STAGE(PG8_SA(1, 0), a3, voffA);
            PG8_BAR; PG8_WAIT_L(0); PG8_MMA(1, 0, At, B0); PG8_BAR; PG8_SCHED;
            PG8_STAGE(PG8_SB(1, 1), b3 + hstep, voffB);
            PG8_WAIT_V(6); PG8_BAR; PG8_MMA(1, 1, At, B1); PG8_BAR;
            }
        }
        if constexpr (ALIGN_EPI) { if (wr == 0) PG8_BAR; }
        if constexpr (!Epi::AFTER_DRAIN) { E(acc, cur, wr, wc, fr, fq); S.done(cur); }
        if (!has_next) break;
#pragma unroll
        for (int a = 0; a < 2; ++a)
#pragma unroll
            for (int b = 0; b < 2; ++b)
#pragma unroll
                for (int m = 0; m < 4; ++m)
#pragma unroll
                    for (int n = 0; n < 2; ++n) acc[a][b][m][n] = (f32x4){0.f, 0.f, 0.f, 0.f};
        cur = nxt; cA = nA; cB = nB; ++ui;
        if constexpr (ALIGN_EPI) { if (wr == 1) PG8_BAR; }
    }
    PG8_WAIT_V(0);
    if constexpr (!ALIGN_EPI) { if (wr == 0) PG8_BAR; }
    PG8_BAR;
    if constexpr (Epi::AFTER_DRAIN) { E.fused(acc, cur, wr, wc, fr, fq, lds, wid, lane); S.done(cur); }
#undef PG8_SA
#undef PG8_SB
#undef PG8_STAGE
#undef PG8_LDA
#undef PG8_LDB
#undef PG8_MMA
#undef PG8_WAIT_V
#undef PG8_WAIT_L
#undef PG8_BAR
#undef PG8_SCHED
}
}
#define XB_TMO      128
#define XB_XCNT(j)  (256  + 64 * (j))
#define XB_XSUB(j)  (1280 + 64 * (j))
#define XB_XGEN(j)  (2304 + 64 * (j))
#define XB_TOP      3328
#define XB_TOPGEN   3392
#define XCD_BAR_WORDS 3456
#define XB_SPIN_CAP (1u << 18)

__device__ __forceinline__ unsigned xb_ld(unsigned* p)              { return __hip_atomic_load(p, __ATOMIC_RELAXED, __HIP_MEMORY_SCOPE_AGENT); }
__device__ __forceinline__ unsigned xb_add(unsigned* p, unsigned v) { return __hip_atomic_fetch_add(p, v, __ATOMIC_RELAXED, __HIP_MEMORY_SCOPE_AGENT); }
__device__ __forceinline__ unsigned xb_xcc_id() { return (unsigned)__builtin_amdgcn_s_getreg((3 << 11) | 20) & 0xFu; }
#define XB_SPIN(cond, bar) do { unsigned _sp = 0; while (cond) { __builtin_amdgcn_s_sleep(1); \
    if ((++_sp & 255u) == 0u) { if (xb_ld(&(bar)[XB_TMO])) break; if (_sp > XB_SPIN_CAP) { atomicAdd(&(bar)[XB_TMO], 1u); break; } } } } while (0)

struct XcdBarrier {
    unsigned* bar; unsigned x;
    volatile LAS unsigned* st;
};

__device__ __forceinline__ XcdBarrier xcd_barrier_post(unsigned* bar, volatile LAS unsigned* st) {
    XcdBarrier b; b.bar = bar; b.x = xb_xcc_id(); b.st = st;
    if (threadIdx.x == 0) (void)xb_add(&bar[XB_XCNT(b.x)], 1u);
    return b;
}
__device__ __forceinline__ void xcd_barrier_complete(unsigned* bar, unsigned x, unsigned& nloc, unsigned& nx) {
    const unsigned G = gridDim.x * gridDim.y * gridDim.z;
    unsigned sum, cnt, mine, sp = 0u;
    for (;;) {
        sum = 0u; cnt = 0u; mine = 0u;
#pragma unroll
        for (unsigned j = 0; j < 16; ++j) { const unsigned c = xb_ld(&bar[XB_XCNT(j)]); sum += c; cnt += (c > 0u) ? 1u : 0u; mine = (j == x) ? c : mine; }
        if (sum == G) break;
        __builtin_amdgcn_s_sleep(1);
        if ((++sp & 255u) == 0u) { if (xb_ld(&bar[XB_TMO])) break; if (sp > XB_SPIN_CAP) { atomicAdd(&bar[XB_TMO], 1u); break; } }
    }
    nloc = mine > 0u ? mine : 1u; nx = cnt > 0u ? cnt : 1u;
}

__device__ __forceinline__ void xcd_barrier(const XcdBarrier& b) {
    asm volatile("s_waitcnt vmcnt(0)" ::: "memory");
    __syncthreads();
    if (threadIdx.x == 0) {
        unsigned* bar = b.bar;
        __builtin_amdgcn_s_waitcnt(0);
        unsigned nloc = b.st[0], nx = b.st[1];
        if (nloc == 0u) { xcd_barrier_complete(bar, b.x, nloc, nx); b.st[0] = nloc; b.st[1] = nx; }
        const unsigned old = xb_add(&bar[XB_XSUB(b.x)], 1u);
        const unsigned gen = old / nloc;
        if (old + 1u == (gen + 1u) * nloc) {
            __builtin_amdgcn_fence(__ATOMIC_RELEASE, "agent");
            asm volatile("s_waitcnt vmcnt(0)" ::: "memory");
            const unsigned og = xb_add(&bar[XB_TOP], 1u);
            const unsigned tg = og / nx;
            if (og + 1u == (tg + 1u) * nx) xb_add(&bar[XB_TOPGEN], 1u);
            else XB_SPIN(xb_ld(&bar[XB_TOPGEN]) == tg, bar);
            __builtin_amdgcn_fence(__ATOMIC_ACQUIRE, "agent");
            xb_add(&bar[XB_XGEN(b.x)], 1u);
            asm volatile("s_waitcnt vmcnt(0)" ::: "memory");
        } else {
            XB_SPIN(xb_ld(&bar[XB_XGEN(b.x)]) == gen, bar);
            __builtin_amdgcn_fence(__ATOMIC_ACQUIRE, "agent");
            asm volatile("s_waitcnt vmcnt(0)" ::: "memory");
        }
    }
    __syncthreads();
}

struct Args { const float* in[N_INPUTS]; float* out; unsigned char* ws; int ph_lo, ph_hi; };
static_assert(sizeof(Args) == N_INPUTS * 8 + 8 + 8 + 8, "Args has no padding");

__device__ __forceinline__ unsigned long long ldptr(const LAS unsigned long long* t, int k) {
    const unsigned long long v = t[k]; const unsigned lo = __builtin_amdgcn_readfirstlane((unsigned)v), hi = __builtin_amdgcn_readfirstlane((unsigned)(v >> 32)); return ((unsigned long long)hi << 32) | lo; }
struct Frame {
    LAS unsigned char* lds; int tid, lane, wave, G, gw, ngw; long gtid, nthreads;
};

__device__ __forceinline__ void p0_transpose_item(const float* W, int K, int N, bf16_t* WT, const float* gain, LAS float* scr, int item, int lane) {
    const int nblk = N / 64, kb = item / nblk, nb = item % nblk, k0 = 64 * kb, n0 = 64 * nb;
    const int kr = lane >> 4, n4 = (lane & 15) * 4;
    f32x4 v[16];
#pragma unroll
    for (int i = 0; i < 16; ++i) v[i] = *(const f32x4*)(W + (size_t)(k0 + 4 * i + kr) * N + n0 + n4);
    if (gain) {
#pragma unroll
        for (int i = 0; i < 16; ++i) v[i] *= gain[k0 + 4 * i + kr];
    }
#pragma unroll
    for (int i = 0; i < 16; ++i) { LAS float* d = scr + (4 * i + kr) * 65 + n4; d[0] = v[i][0]; d[1] = v[i][1]; d[2] = v[i][2]; d[3] = v[i][3]; }
    LDS_WAIT(); asm volatile("" ::: "memory");
    const int c = lane & 7;
#pragma unroll
    for (int j = 0; j < 8; ++j) { const int n = (lane >> 3) + 8 * j; const LAS float* s = scr + (8 * c) * 65 + n;
        u32x4 o; o.x = pk2(s[0 * 65], s[1 * 65]); o.y = pk2(s[2 * 65], s[3 * 65]); o.z = pk2(s[4 * 65], s[5 * 65]); o.w = pk2(s[6 * 65], s[7 * 65]);
        *(u32x4*)(WT + (size_t)(n0 + n) * K + k0 + 8 * c) = o; }
    LDS_WAIT(); asm volatile("" ::: "memory");
}
struct Mat { const float* W; int K, N; bf16_t* WT; const float* gain; };
__device__ __forceinline__ Mat get_mat(const Args& a, int id) {
    Mat m; unsigned char* ws = a.ws;
    if (id < 2)       { m.W = a.in[I_LWIN] + (size_t)id * D * N_IN_LRU; m.K = D; m.N = N_IN_LRU; m.WT = (bf16_t*)(ws + WS_WINL + id * SZ_WINL); m.gain = a.in[I_NMIX] + (2 * id) * D; }
    else if (id < 4)  { const int j = id - 2; m.W = a.in[I_AWIN] + (size_t)j * D * N_IN_ATT; m.K = D; m.N = N_IN_ATT; m.WT = (bf16_t*)(ws + WS_WINA + j * SZ_WINA); m.gain = a.in[I_NMIX] + (2 * j + 1) * D; }
    else if (id < 8)  { const int i = id - 4; m.W = ((i & 1) ? a.in[I_AWOUT] : a.in[I_LWOUT]) + (size_t)(i >> 1) * K_OUT * D; m.K = K_OUT; m.N = D; m.WT = (bf16_t*)(ws + WS_WOUT + i * SZ_WOUT); m.gain = nullptr; }
    else if (id < 12) { const int i = id - 8; m.W = a.in[I_FUP] + (size_t)i * D * N_UP; m.K = D; m.N = N_UP; m.WT = (bf16_t*)(ws + WS_WUP + i * SZ_WUP); m.gain = a.in[I_NFFN] + i * D; }
    else if (id < 16) { const int i = id - 12; m.W = a.in[I_FDN] + (size_t)i * DFF * D; m.K = DFF; m.N = D; m.WT = (bf16_t*)(ws + WS_WDN + i * SZ_WDN); m.gain = nullptr; }
    else if (id < 20) { const int i = id - 16; m.W = a.in[I_MWKV] + (size_t)i * D * 2048; m.K = D; m.N = 2048; m.WT = (bf16_t*)(ws + WS_WKV) + (size_t)i * 2048 * D; m.gain = a.in[I_MNORM] + i * D; }
    else { const int g = id - 20, j = g >> 4, h = (g >> 1) & 7, which = g & 1;
        m.W = (which ? a.in[I_LGXW] : a.in[I_LGAW]) + (size_t)(j * 8 + h) * 256 * 256; m.K = 256; m.N = 256; m.WT = (bf16_t*)(ws + WS_WG + j * SZ_WG) + ((size_t)h * 512 + which * 256) * 256; m.gain = nullptr; }
    return m;
}
constexpr int N_MATS = 52;

__device__ __forceinline__ void p0_prologue(const Args& a, const Frame& F) {
    unsigned char* ws = a.ws;
    LAS float* scr = (LAS float*)(F.lds + F.wave * 16640);
    int rot = 0;
    for (int id = 0; id < N_MATS; ++id) {
        const Mat m = get_mat(a, id); const int nitems = (m.K / 64) * (m.N / 64);
        int first = F.gw - rot; if (first < 0) first += F.ngw;
        for (int it = first; it < nitems; it += F.ngw) p0_transpose_item(m.W, m.K, m.N, m.WT, m.gain, scr, it, F.lane);
        rot = (rot + nitems) % F.ngw;
    }
    {
        bf16_t* xb = (bf16_t*)(ws + WS_XB); float* ssa = (float*)(ws + WS_SSA);
        for (int m = F.gw; m < M; m += F.ngw) {
            const float* src = (m < MP) ? a.in[I_XP] + (size_t)m * D : a.in[I_XS] + (size_t)(m - MP) * D;
            const f32x4* xr = (const f32x4*)src + F.lane; u32x2* o = (u32x2*)(xb + (size_t)m * D) + F.lane; float s = 0.f;
#pragma unroll
            for (int j = 0; j < 8; ++j) { const f32x4 v = xr[64 * j]; s += (v[0] * v[0] + v[1] * v[1]) + (v[2] * v[2] + v[3] * v[3]); u32x2 w; w.x = pk2(v[0], v[1]); w.y = pk2(v[2], v[3]); o[64 * j] = w; }
            s = wave_sum(s);
            if (F.lane < 8) ssa[(size_t)m * 8 + F.lane] = (F.lane == 0) ? s : 0.f;
        }
    }
    {
        bf16_t* mb = (bf16_t*)(ws + WS_MEMB); float* mrs = (float*)(ws + WS_MEMRS);
        for (int m = F.gw; m < 512; m += F.ngw) {
            const f32x4* xr = (const f32x4*)(a.in[I_MEM] + (size_t)m * D) + F.lane; u32x2* o = (u32x2*)(mb + (size_t)m * D) + F.lane; float s = 0.f;
#pragma unroll
            for (int j = 0; j < 8; ++j) { const f32x4 v = xr[64 * j]; s += (v[0] * v[0] + v[1] * v[1]) + (v[2] * v[2] + v[3] * v[3]); u32x2 w; w.x = pk2(v[0], v[1]); w.y = pk2(v[2], v[3]); o[64 * j] = w; }
            s = wave_sum(s);
            if (F.lane == 0) mrs[m] = 1.0f / sqrtf(s * (1.0f / 2048.0f) + EPS);
        }
    }
    {
        const size_t n4[4] = {(size_t)2 * NBS * PAST * D / 4, (size_t)2 * NBS * PAST * D / 4, (size_t)4 * NBS * MEMT * MEMW / 4, (size_t)4 * NBS * MEMT * MEMW / 4};
        const float* srcs[4] = {a.in[I_CAK], a.in[I_CAV], a.in[I_CMK], a.in[I_CMV]};
        unsigned char* dsts[4] = {ws + WS_CAK, ws + WS_CAV, ws + WS_CMK, ws + WS_CMV};
#pragma unroll
        for (int q = 0; q < 4; ++q) { const f32x4* s = (const f32x4*)srcs[q]; u32x2* d = (u32x2*)dsts[q];
            for (size_t i = (size_t)F.gtid; i < n4[q]; i += (size_t)F.nthreads) { const f32x4 v = s[i]; u32x2 w; w.x = pk2(v[0], v[1]); w.y = pk2(v[2], v[3]); d[i] = w; } }
    }
    {
        float* cl8 = (float*)(ws + WS_CL8);
        for (long i = F.gtid; i < 2 * 2048; i += F.nthreads) { const float L = a.in[I_LLAM][i]; cl8[i] = 8.0f * (fminf(L, 0.f) - log1pf(expf(-fabsf(L)))); }
    }
}

__device__ __forceinline__ void ffn_act_phase(const Args& a, const Frame& F, int i) {
    const bf16_t* up = (const bf16_t*)(a.ws + WS_UP); bf16_t* act = (bf16_t*)(a.ws + WS_ACT);
    const float* cw = a.in[I_FCW] + (size_t)i * 3 * N_UP; const float* cb = a.in[I_FCB] + (size_t)i * N_UP; const float* st = a.in[I_SFC] + (size_t)i * NBS * 2 * N_UP;
    constexpr int NCH = DFF / 8, NRG = M / 8;
    for (long item = F.gtid; item < (long)NRG * NCH; item += F.nthreads) {
        const int rgp = (int)(item / NCH), cc = (int)(item % NCH), c0 = cc * 8, row0 = rgp * 8;
        float wg[3][8], wu[3][8], bg[8], bu[8];
#pragma unroll
        for (int k = 0; k < 3; ++k)
#pragma unroll
            for (int h = 0; h < 2; ++h) { const f32x4 g4 = *(const f32x4*)(cw + (size_t)k * N_UP + c0 + 4 * h), u4 = *(const f32x4*)(cw + (size_t)k * N_UP + DFF + c0 + 4 * h);
#pragma unroll
                for (int e = 0; e < 4; ++e) { wg[k][4 * h + e] = g4[e]; wu[k][4 * h + e] = u4[e]; } }
#pragma unroll
        for (int h = 0; h < 2; ++h) { const f32x4 g4 = *(const f32x4*)(cb + c0 + 4 * h), u4 = *(const f32x4*)(cb + DFF + c0 + 4 * h);
#pragma unroll
            for (int e = 0; e < 4; ++e) { bg[4 * h + e] = g4[e]; bu[4 * h + e] = u4[e]; } }
        float g2[8], g1[8], u2[8], u1[8];
        int t0, b; bool sample;
        if (row0 < MP) { b = row0 >> 12; t0 = row0 & 4095; sample = false; } else { const int r2 = row0 - MP; b = r2 >> 6; t0 = r2 & 63; sample = true; }
        if (t0 == 0) {
            if (sample) {
#pragma unroll
                for (int h = 0; h < 2; ++h) { const float* s0 = st + ((size_t)b * 2 + 0) * N_UP, *s1 = st + ((size_t)b * 2 + 1) * N_UP;
                    const f32x4 a0 = *(const f32x4*)(s0 + c0 + 4 * h), a1 = *(const f32x4*)(s1 + c0 + 4 * h), b0 = *(const f32x4*)(s0 + DFF + c0 + 4 * h), b1 = *(const f32x4*)(s1 + DFF + c0 + 4 * h);
#pragma unroll
                    for (int e = 0; e < 4; ++e) { g2[4 * h + e] = a0[e]; g1[4 * h + e] = a1[e]; u2[4 * h + e] = b0[e]; u1[4 * h + e] = b1[e]; } }
            } else {
#pragma unroll
                for (int e = 0; e < 8; ++e) { g2[e] = 0.f; g1[e] = 0.f; u2[e] = 0.f; u1[e] = 0.f; }
            }
        } else {
            const u32x4 a0 = *(const u32x4*)(up + (size_t)(row0 - 2) * N_UP + c0), a1 = *(const u32x4*)(up + (size_t)(row0 - 1) * N_UP + c0);
            const u32x4 b0 = *(const u32x4*)(up + (size_t)(row0 - 2) * N_UP + DFF + c0), b1 = *(const u32x4*)(up + (size_t)(row0 - 1) * N_UP + DFF + c0);
#pragma unroll
            for (int e = 0; e < 4; ++e) { g2[2 * e] = bf_lo(a0[e]); g2[2 * e + 1] = bf_hi(a0[e]); g1[2 * e] = bf_lo(a1[e]); g1[2 * e + 1] = bf_hi(a1[e]);
                                          u2[2 * e] = bf_lo(b0[e]); u2[2 * e + 1] = bf_hi(b0[e]); u1[2 * e] = bf_lo(b1[e]); u1[2 * e + 1] = bf_hi(b1[e]); }
        }
#pragma unroll
        for (int r = 0; r < 8; ++r) {
            const u32x4 ga = *(const u32x4*)(up + (size_t)(row0 + r) * N_UP + c0), ua = *(const u32x4*)(up + (size_t)(row0 + r) * N_UP + DFF + c0);
            float gc[8], uc[8], o[8];
#pragma unroll
            for (int e = 0; e < 4; ++e) { gc[2 * e] = bf_lo(ga[e]); gc[2 * e + 1] = bf_hi(ga[e]); uc[2 * e] = bf_lo(ua[e]); uc[2 * e + 1] = bf_hi(ua[e]); }
#pragma unroll
            for (int e = 0; e < 8; ++e) { const float yg = bg[e] + wg[0][e] * g2[e] + wg[1][e] * g1[e] + wg[2][e] * gc[e], yu = bu[e] + wu[0][e] * u2[e] + wu[1][e] * u1[e] + wu[2][e] * uc[e];
                o[e] = gelu_tanh(yg) * yu; g2[e] = g1[e]; g1[e] = gc[e]; u2[e] = u1[e]; u1[e] = uc[e]; }
            u32x4 w; w.x = pk2(o[0], o[1]); w.y = pk2(o[2], o[3]); w.z = pk2(o[4], o[5]); w.w = pk2(o[6], o[7]);
            *(u32x4*)(act + (size_t)(row0 + r) * DFF + c0) = w;
        }
    }
}

__device__ __forceinline__ void lru_b_phase(const Args& a, const Frame& F, int j) {
    const float* hloc = (const float*)(a.ws + WS_HLOC); const float* pcum = (const float*)(a.ws + WS_PCUM);
    const float* agga = (const float*)(a.ws + WS_AGGA); const float* aggh = (const float*)(a.ws + WS_AGGH);
    const bf16_t* gate = (const bf16_t*)(a.ws + WS_Z0); bf16_t* aout = (bf16_t*)(a.ws + WS_AOUT);
    for (long item = F.gtid; item < 144L * 512; item += F.nthreads) {
        const int rt = (int)(item >> 9), ch = ((int)item & 511) * 4;
        f32x4 H; int b; float* so = nullptr;
        if (rt < 128) { b = rt >> 6; const int q = rt & 63; H = (f32x4){0.f, 0.f, 0.f, 0.f};
            for (int p = 0; p < q; ++p) { const f32x4 A = *(const f32x4*)(agga + (size_t)(b * 64 + p) * D + ch), Hh = *(const f32x4*)(aggh + (size_t)(b * 64 + p) * D + ch); H = A * H + Hh; }
            if (q == 63) so = a.out + O_PLH + (size_t)(j * NBP + b) * D + ch;
        } else { b = rt - 128; H = *(const f32x4*)(a.in[I_SLH] + (size_t)(j * NBS + b) * D + ch); so = a.out + O_SLH + (size_t)(j * NBS + b) * D + ch; }
        for (int r = 0; r < 64; ++r) { const size_t row = (size_t)rt * 64 + r;
            const f32x4 hl = *(const f32x4*)(hloc + row * D + ch), pc = *(const f32x4*)(pcum + row * D + ch); const u32x2 gt = *(const u32x2*)(gate + row * D + ch);
            const f32x4 hv = hl + pc * H;
            const float m0 = gelu_tanh(bf_lo(gt.x)) * hv[0], m1 = gelu_tanh(bf_hi(gt.x)) * hv[1], m2 = gelu_tanh(bf_lo(gt.y)) * hv[2], m3 = gelu_tanh(bf_hi(gt.y)) * hv[3];
            u32x2 w; w.x = pk2(m0, m1); w.y = pk2(m2, m3); *(u32x2*)(aout + row * K_OUT + ch) = w;
            if (r == 63 && so) *(f32x4*)so = hv; }
    }
}

#define WG_BAR() do { asm volatile("s_waitcnt lgkmcnt(0)" ::: "memory"); __builtin_amdgcn_s_barrier(); asm volatile("" ::: "memory"); } while (0)
constexpr int KSTR = 528, VSTR = 544;
constexpr int KT_BYTES = 64 * KSTR, VT_BYTES = 64 * VSTR, TILE_BYTES = KT_BYTES + VT_BYTES;
static_assert(2 * TILE_BYTES <= LDS_MISC, "attention LDS");
typedef short v4i16_t __attribute__((ext_vector_type(4)));
__device__ __forceinline__ f32x4 mfma16(bf16x8 a, bf16x8 b, f32x4 c) { return __builtin_amdgcn_mfma_f32_16x16x32_bf16(a, b, c, 0, 0, 0); }
__device__ __forceinline__ s16x4 vtr(const LAS unsigned char* p) { return __builtin_bit_cast(s16x4, __builtin_amdgcn_ds_read_tr16_b64_v4i16((LAS v4i16_t*)p)); }
__device__ __forceinline__ unsigned cvtpk(float lo, float hi) { unsigned r; asm volatile("v_cvt_pk_bf16_f32 %0, %1, %2" : "=v"(r) : "v"(lo), "v"(hi)); return r; }

struct AttnU {
    const bf16_t* Q; int ldq;
    const bf16_t* K0; const bf16_t* V0; int ld0; int nt0;
    const bf16_t* K1; const bf16_t* V1; int ld1;
    int nt, stagger, nqw;
    bf16_t* O; int ldo;
    float lam, osc; const float* gsub;
};
__device__ __forceinline__ void tile_load(const bf16_t* base, int ld, int tid, u32x4 (&r)[4]) {
#pragma unroll
    for (int i = 0; i < 4; ++i) { const int id = tid + 512 * i, row = id >> 5, cc = id & 31; r[i] = *(const u32x4*)(base + (size_t)row * ld + cc * 8); }
}
__device__ __forceinline__ void tile_commit(LAS unsigned char* dst, int stride, int tid, const u32x4 (&r)[4]) {
#pragma unroll
    for (int i = 0; i < 4; ++i) { const int id = tid + 512 * i, row = id >> 5, cc = id & 31; *(LAS u32x4*)(dst + row * stride + cc * 16) = r[i]; }
}
__device__ __forceinline__ void sm_update(float& m, float& l, const f32x4 (&s)[4]) {
    float tm = fmaxf(fmaxf(s[0][0], s[0][1]), fmaxf(s[0][2], s[0][3]));
#pragma unroll
    for (int k = 1; k < 4; ++k) tm = fmaxf(tm, fmaxf(fmaxf(s[k][0], s[k][1]), fmaxf(s[k][2], s[k][3])));
    const float mn = fmaxf(m, tm); float acc = 0.f;
#pragma unroll
    for (int k = 0; k < 4; ++k) acc += (fexp2(s[k][0] - mn) + fexp2(s[k][1] - mn)) + (fexp2(s[k][2] - mn) + fexp2(s[k][3] - mn));
    l = l * fexp2(m - mn) + acc; m = mn;
}
__device__ __forceinline__ void sm_combine(float& m, float& l) {
    float mo = fmaxf(m, __shfl_xor(m, 16)); mo = fmaxf(mo, __shfl_xor(mo, 32));
    float ls = l * fexp2(m - mo); ls += __shfl_xor(ls, 16); ls += __shfl_xor(ls, 32);
    m = mo; l = 1.0f / ls;
}

template <int MODE  >
__device__ __forceinline__ void attn_unit(LAS unsigned char* lds, const AttnU& u, int tid, int wid, int lane) {
    const int lq = lane & 15, g = lane >> 4;
    const bool active = wid < u.nqw;
    const int nvis = u.nt - ((u.stagger && wid < 4) ? 1 : 0);
    bf16x8 qf[8];
    { const bf16_t* qp = u.Q + (size_t)(16 * (active ? wid : 0) + lq) * u.ldq + 8 * g;
#pragma unroll
      for (int ks = 0; ks < 8; ++ks) qf[ks] = *(const bf16x8*)(qp + 32 * ks); }
    float m1 = -INFINITY, m2 = -INFINITY, l1 = 0.f, l2 = 0.f;
    {
        u32x4 kr[4];
        tile_load(u.nt0 > 0 ? u.K0 : u.K1, u.nt0 > 0 ? u.ld0 : u.ld1, tid, kr);
        tile_commit(lds, KSTR, tid, kr);
        WG_BAR();
        for (int kt = 0; kt < u.nt; ++kt) {
            const bool more = kt + 1 < u.nt;
            if (more) { const int k2 = kt + 1; if (k2 < u.nt0) tile_load(u.K0 + (size_t)k2 * 64 * u.ld0, u.ld0, tid, kr); else tile_load(u.K1 + (size_t)(k2 - u.nt0) * 64 * u.ld1, u.ld1, tid, kr); }
            if (active && kt < nvis) {
                const LAS unsigned char* kp = lds + (kt & 1) * TILE_BYTES + lq * KSTR + 16 * g;
                f32x4 s1[4], s2[4];
#pragma unroll
                for (int kb = 0; kb < 4; ++kb) { f32x4 x = {0.f, 0.f, 0.f, 0.f}, y = {0.f, 0.f, 0.f, 0.f};
#pragma unroll
                    for (int ks = 0; ks < 4; ++ks) { x = mfma16(*(const LAS bf16x8*)(kp + kb * 16 * KSTR + 64 * ks), qf[ks], x); y = mfma16(*(const LAS bf16x8*)(kp + kb * 16 * KSTR + 256 + 64 * ks), qf[4 + ks], y); }
                    s1[kb] = x; s2[kb] = y; }
                if (MODE == 0) { sm_update(m1, l1, s1); sm_update(m2, l2, s2); }
                else {
#pragma unroll
                    for (int kb = 0; kb < 4; ++kb) s1[kb] += s2[kb];
                    sm_update(m1, l1, s1); }
            }
            if (more) tile_commit(lds + ((kt + 1) & 1) * TILE_BYTES, KSTR, tid, kr);
            WG_BAR();
        }
    }
    float il1, il2 = 0.f;
    { float l = l1; sm_combine(m1, l); il1 = l; if (MODE == 0) { float q = l2; sm_combine(m2, q); il2 = q * u.lam; } }
    f32x4 o[16];
#pragma unroll
    for (int db = 0; db < 16; ++db) o[db] = (f32x4){0.f, 0.f, 0.f, 0.f};
    {
        u32x4 kr[4], vr[4];
        tile_load(u.nt0 > 0 ? u.K0 : u.K1, u.nt0 > 0 ? u.ld0 : u.ld1, tid, kr);
        tile_load(u.nt0 > 0 ? u.V0 : u.V1, u.nt0 > 0 ? u.ld0 : u.ld1, tid, vr);
        tile_commit(lds, KSTR, tid, kr); tile_commit(lds + KT_BYTES, VSTR, tid, vr);
        WG_BAR();
        const int qq = lq >> 2, p = lane & 3;
        for (int kt = 0; kt < u.nt; ++kt) {
            const bool more = kt + 1 < u.nt;
            if (more) { const int k2 = kt + 1;
                if (k2 < u.nt0) { tile_load(u.K0 + (size_t)k2 * 64 * u.ld0, u.ld0, tid, kr); tile_load(u.V0 + (size_t)k2 * 64 * u.ld0, u.ld0, tid, vr); }
                else { tile_load(u.K1 + (size_t)(k2 - u.nt0) * 64 * u.ld1, u.ld1, tid, kr); tile_load(u.V1 + (size_t)(k2 - u.nt0) * 64 * u.ld1, u.ld1, tid, vr); } }
            if (active && kt < nvis) {
                const LAS unsigned char* kp = lds + (kt & 1) * TILE_BYTES + lq * KSTR + 16 * g;
                const LAS unsigned char* vp = lds + (kt & 1) * TILE_BYTES + KT_BYTES + (4 * g + qq) * VSTR + 8 * p;
#pragma unroll
                for (int s2i = 0; s2i < 2; ++s2i) {
                    f32x4 w[2];
#pragma unroll
                    for (int kk = 0; kk < 2; ++kk) { const int kb = 2 * s2i + kk; f32x4 x = {0.f, 0.f, 0.f, 0.f}, y = {0.f, 0.f, 0.f, 0.f};
#pragma unroll
                        for (int ks = 0; ks < 4; ++ks) { x = mfma16(*(const LAS bf16x8*)(kp + kb * 16 * KSTR + 64 * ks), qf[ks], x); y = mfma16(*(const LAS bf16x8*)(kp + kb * 16 * KSTR + 256 + 64 * ks), qf[4 + ks], y); }
#pragma unroll
                        for (int e = 0; e < 4; ++e) w[kk][e] = (MODE == 0) ? fexp2(x[e] - m1) * il1 - fexp2(y[e] - m2) * il2 : fexp2(x[e] + y[e] - m1) * il1; }
                    u32x4 pw; pw.x = cvtpk(w[0][0], w[0][1]); pw.y = cvtpk(w[0][2], w[0][3]); pw.z = cvtpk(w[1][0], w[1][1]); pw.w = cvtpk(w[1][2], w[1][3]);
                    const bf16x8 pb = __builtin_bit_cast(bf16x8, pw);
#pragma unroll
                    for (int db = 0; db < 16; ++db) { const s16x4 lo = vtr(vp + s2i * 32 * VSTR + db * 32), hi = vtr(vp + (s2i * 32 + 16) * VSTR + db * 32);
                        const bf16x8 va = __builtin_shufflevector(lo, hi, 0, 1, 2, 3, 4, 5, 6, 7);
                        o[db] = mfma16(va, pb, o[db]); }
                }
            }
            if (more) { tile_commit(lds + ((kt + 1) & 1) * TILE_BYTES, KSTR, tid, kr); tile_commit(lds + ((kt + 1) & 1) * TILE_BYTES + KT_BYTES, VSTR, tid, vr); }
            WG_BAR();
        }
    }
    if (active) {
        bf16_t* op = u.O + (size_t)(16 * wid + lq) * u.ldo + 4 * g;
        if (MODE == 0) {
            float ss = 0.f;
#pragma unroll
            for (int db = 0; db < 16; ++db) ss += (o[db][0] * o[db][0] + o[db][1] * o[db][1]) + (o[db][2] * o[db][2] + o[db][3] * o[db][3]);
            ss += __shfl_xor(ss, 16); ss += __shfl_xor(ss, 32);
            const float rn = __builtin_amdgcn_rsqf(ss * (1.0f / 256.0f) + EPS) * u.osc;
#pragma unroll
            for (int db = 0; db < 16; ++db) { const f32x4 gv = *(const f32x4*)(u.gsub + 16 * db + 4 * g); const f32x4 v = o[db] * rn * gv;
                u32x2 wv; wv.x = cvtpk(v[0], v[1]); wv.y = cvtpk(v[2], v[3]); *(u32x2*)(op + 16 * db) = wv; }
        } else {
#pragma unroll
            for (int db = 0; db < 16; ++db) { u32x2 wv; wv.x = cvtpk(o[db][0], o[db][1]); wv.y = cvtpk(o[db][2], o[db][3]); *(u32x2*)(op + 16 * db) = wv; }
        }
    }
}

__device__ __forceinline__ void lru_a_unit(const Args& a, LAS unsigned char* lds, int j, int rt, int h, int tid, int wid, int lane) {
    LAS unsigned char* XC = lds;
    const bf16_t* xr = (const bf16_t*)(a.ws + WS_Z1);
    const int lq = lane & 15, g = lane >> 4;
    const int row0 = rt * 64; const bool sample = rt >= 128; const int b = sample ? rt - 128 : rt >> 6; const int pos0 = sample ? 0 : (rt & 63) * 64;
    {
        const int c8 = tid & 31, rg = tid >> 5, ch0 = h * 256 + c8 * 8;
        const float* cw = a.in[I_LCW] + (size_t)j * 4 * D + ch0; const float* cb = a.in[I_LCB] + (size_t)j * D + ch0;
        float w[4][8], bias[8], xv[7][8];
#pragma unroll
        for (int k = 0; k < 4; ++k)
#pragma unroll
            for (int hh = 0; hh < 2; ++hh) { const f32x4 t = *(const f32x4*)(cw + (size_t)k * D + 4 * hh);
#pragma unroll
                for (int e = 0; e < 4; ++e) w[k][4 * hh + e] = t[e]; }
#pragma unroll
        for (int hh = 0; hh < 2; ++hh) { const f32x4 t = *(const f32x4*)(cb + 4 * hh);
#pragma unroll
            for (int e = 0; e < 4; ++e) bias[4 * hh + e] = t[e]; }
#pragma unroll
        for (int d = 0; d < 7; ++d) { const int t = 4 * rg + d - 3;
            if (pos0 + t >= 0) { const u32x4 v = *(const u32x4*)(xr + (size_t)(row0 + t) * D + ch0);
#pragma unroll
                for (int e = 0; e < 4; ++e) { xv[d][2 * e] = bf_lo(v[e]); xv[d][2 * e + 1] = bf_hi(v[e]); } }
            else if (sample) { const float* s = a.in[I_SLC] + ((size_t)(j * NBS + b) * 3 + (3 + t)) * D + ch0; const f32x4 s0 = *(const f32x4*)s, s1 = *(const f32x4*)(s + 4);
#pragma unroll
                for (int e = 0; e < 4; ++e) { xv[d][e] = s0[e]; xv[d][4 + e] = s1[e]; } }
            else {
#pragma unroll
                for (int e = 0; e < 8; ++e) xv[d][e] = 0.f; } }
#pragma unroll
        for (int r = 0; r < 4; ++r) { float y[8];
#pragma unroll
            for (int e = 0; e < 8; ++e) y[e] = bias[e] + w[0][e] * xv[r][e] + w[1][e] * xv[r + 1][e] + w[2][e] * xv[r + 2][e] + w[3][e] * xv[r + 3][e];
            u32x4 pw; pw.x = pk2(y[0], y[1]); pw.y = pk2(y[2], y[3]); pw.z = pk2(y[4], y[5]); pw.w = pk2(y[6], y[7]);
            *(LAS u32x4*)(XC + (4 * rg + r) * KSTR + c8 * 16) = pw; }
    }
    WG_BAR();
    f32x4 ca[4][2], cx[4][2];
#pragma unroll
    for (int mb = 0; mb < 4; ++mb)
#pragma unroll
        for (int nb = 0; nb < 2; ++nb) { ca[mb][nb] = (f32x4){0.f, 0.f, 0.f, 0.f}; cx[mb][nb] = (f32x4){0.f, 0.f, 0.f, 0.f}; }
    {
        const bf16_t* wpa = (const bf16_t*)(a.ws + WS_WG + (size_t)j * SZ_WG) + (size_t)h * 512 * 256 + (size_t)(32 * wid + lq) * 256 + 8 * g;
        const LAS unsigned char* ap = XC + lq * KSTR + 16 * g;
#pragma unroll 2
        for (int ks = 0; ks < 8; ++ks) {
            bf16x8 af[4];
#pragma unroll
            for (int mb = 0; mb < 4; ++mb) af[mb] = *(const LAS bf16x8*)(ap + mb * 16 * KSTR + 64 * ks);
#pragma unroll
            for (int nb = 0; nb < 2; ++nb) { const bf16x8 ba = *(const bf16x8*)(wpa + nb * 16 * 256 + 32 * ks), bx = *(const bf16x8*)(wpa + 256 * 256 + nb * 16 * 256 + 32 * ks);
#pragma unroll
                for (int mb = 0; mb < 4; ++mb) { ca[mb][nb] = mfma16(af[mb], ba, ca[mb][nb]); cx[mb][nb] = mfma16(af[mb], bx, cx[mb][nb]); } }
        }
    }
    float* hloc = (float*)(a.ws + WS_HLOC); float* pcum = (float*)(a.ws + WS_PCUM);
#pragma unroll
    for (int nb = 0; nb < 2; ++nb) {
        const int c = 32 * wid + 16 * nb + lq, ch = h * 256 + c;
        const float ba_ = a.in[I_LGAB][(size_t)j * D + ch], bx_ = a.in[I_LGXB][(size_t)j * D + ch], cl = ((const float*)(a.ws + WS_CL8))[(size_t)j * D + ch] * LOG2E;
        float cA = 1.f, cH = 0.f;
#pragma unroll
        for (int mb = 0; mb < 4; ++mb) {
            float As[4], Hs[4]; float Al = 1.f, Hl = 0.f;
#pragma unroll
            for (int reg = 0; reg < 4; ++reg) { const int t = 16 * mb + 4 * g + reg;
                const float r = sigmoidf_(ca[mb][nb][reg] + ba_), ig = sigmoidf_(cx[mb][nb][reg] + bx_);
                const float av = fexp2(cl * r);
                const float xcv = __builtin_bit_cast(float, (unsigned)(*(const LAS unsigned short*)(XC + t * KSTR + c * 2)) << 16);
                const float gt = sqrtf(fmaxf(1.f - av * av, 0.f)) * (ig * xcv);
                Hl = av * Hl + gt; Al *= av; As[reg] = Al; Hs[reg] = Hl; }
            float Ak[4], Hk[4];
#pragma unroll
            for (int k = 0; k < 4; ++k) { Ak[k] = __shfl(Al, lq + 16 * k); Hk[k] = __shfl(Hl, lq + 16 * k); }
            float PA = cA, PH = cH;
#pragma unroll
            for (int k = 0; k < 3; ++k) if (k < g) { PH = Ak[k] * PH + Hk[k]; PA *= Ak[k]; }
#pragma unroll
            for (int reg = 0; reg < 4; ++reg) { const size_t o = (size_t)(row0 + 16 * mb + 4 * g + reg) * D + ch; hloc[o] = Hs[reg] + As[reg] * PH; pcum[o] = As[reg] * PA; }
#pragma unroll
            for (int k = 0; k < 4; ++k) { cH = Ak[k] * cH + Hk[k]; cA *= Ak[k]; }
        }
        if (g == 0) { ((float*)(a.ws + WS_AGGA))[(size_t)rt * D + ch] = cA; ((float*)(a.ws + WS_AGGH))[(size_t)rt * D + ch] = cH; }
    }
    WG_BAR();
}

template <bool ATT>
__device__ __forceinline__ void mixer_phase(const Args& a, const Frame& F, int i, int qslot) {
    const int j = i >> 1;
    unsigned char* ws = a.ws;
    unsigned* queue = (unsigned*)(ws + WS_CTL) + CW_QUEUE + 64 * qslot;
    volatile LAS unsigned* misc = (volatile LAS unsigned*)(F.lds + LDS_MISC);
    const bf16_t* Z0 = (const bf16_t*)(ws + WS_Z0); const bf16_t* Z1 = (const bf16_t*)(ws + WS_Z1); const bf16_t* Z2 = (const bf16_t*)(ws + WS_Z2);
    const bf16_t* MQ = (const bf16_t*)(ws + WS_MQ); bf16_t* AO = (bf16_t*)(ws + WS_AOUT);
    float lam = 0.f, osc = 0.f;
    if (ATT) {
        const float* lp = a.in[I_ALAM] + (size_t)j * 4 * 128;
        float s1 = lp[F.lane] * lp[128 + F.lane] + lp[64 + F.lane] * lp[192 + F.lane], s2 = lp[256 + F.lane] * lp[384 + F.lane] + lp[320 + F.lane] * lp[448 + F.lane];
        s1 = wave_sum(s1); s2 = wave_sum(s2);
        const float lam_init = 0.8f - 0.6f * expf(-0.3f * (float)i);
        lam = expf(s1) - expf(s2) + lam_init; osc = 1.0f - lam_init;
    }
    constexpr int N_FIRST = ATT ? (NBS * 8 + 16 * 32) : (144 * 8);
    constexpr int N_TOTAL = N_FIRST + 256 + 64;
    for (;;) {
        if (F.tid == 0) misc[0] = __hip_atomic_fetch_add(queue, 1u, __ATOMIC_RELAXED, __HIP_MEMORY_SCOPE_AGENT);
        WG_BAR();
        const int idx = (int)misc[0];
        WG_BAR();
        if (idx >= N_TOTAL) break;
        if (idx < N_FIRST) {
            if (ATT) {
                AttnU u; u.ldq = D; u.ld0 = D; u.ld1 = D; u.ldo = K_OUT; u.lam = lam; u.osc = osc; u.gsub = a.in[I_ASUB] + (size_t)j * 256;
                if (idx < NBS * 8) { const int b = idx >> 3, h = idx & 7; const size_t r0 = (size_t)MP + b * DSEQ;
                    u.Q = Z0 + r0 * D + h * 256; u.K0 = (const bf16_t*)(ws + WS_CAK) + ((size_t)(j * NBS + b) * PAST) * D + h * 256; u.V0 = (const bf16_t*)(ws + WS_CAV) + ((size_t)(j * NBS + b) * PAST) * D + h * 256; u.nt0 = PAST / 64;
                    u.K1 = Z1 + r0 * D + h * 256; u.V1 = Z2 + r0 * D + h * 256; u.nt = PAST / 64 + 1; u.stagger = 0; u.nqw = 4; u.O = AO + r0 * K_OUT + h * 256;
                } else { const int k = idx - NBS * 8, qt = 31 - (k >> 4), bh = k & 15, b = bh >> 3, h = bh & 7; const size_t r0 = (size_t)b * SEQ + 128 * qt;
                    u.Q = Z0 + r0 * D + h * 256; u.K0 = nullptr; u.V0 = nullptr; u.nt0 = 0; u.K1 = Z1 + (size_t)b * SEQ * D + h * 256; u.V1 = Z2 + (size_t)b * SEQ * D + h * 256;
                    u.nt = 2 * qt + 2; u.stagger = 1; u.nqw = 8; u.O = AO + r0 * K_OUT + h * 256; }
                attn_unit<0>(F.lds, u, F.tid, F.wave, F.lane);
            } else {
                lru_a_unit(a, F.lds, j, idx >> 3, idx & 7, F.tid, F.wave, F.lane);
            }
        } else {
            AttnU u; u.ldq = MEMW; u.ld0 = MEMW; u.ld1 = MEMW; u.ldo = K_OUT; u.lam = 0.f; u.osc = 1.f; u.gsub = nullptr; u.stagger = 0; u.nt = 4;
            const int k = idx - N_FIRST;
            if (k < 256) { const int b = k >> 7, h = (k >> 5) & 3, qt = k & 31; const size_t r0 = (size_t)b * SEQ + 128 * qt;
                u.Q = MQ + r0 * MEMW + h * 256; u.K0 = nullptr; u.V0 = nullptr; u.nt0 = 0;
                u.K1 = (const bf16_t*)(ws + WS_MEMK) + ((size_t)i * 512 + b * MEMT) * MEMW + h * 256; u.V1 = (const bf16_t*)(ws + WS_MEMV) + ((size_t)i * 512 + b * MEMT) * MEMW + h * 256;
                u.nqw = 8; u.O = AO + r0 * K_OUT + 2048 + h * 256;
            } else { const int k2 = k - 256, b = k2 >> 2, h = k2 & 3; const size_t r0 = (size_t)MP + b * DSEQ;
                u.Q = MQ + r0 * MEMW + h * 256; u.K0 = (const bf16_t*)(ws + WS_CMK) + ((size_t)(i * NBS + b) * MEMT) * MEMW + h * 256; u.V0 = (const bf16_t*)(ws + WS_CMV) + ((size_t)(i * NBS + b) * MEMT) * MEMW + h * 256; u.nt0 = 4;
                u.K1 = u.K0; u.V1 = u.V0; u.nqw = 4; u.O = AO + r0 * K_OUT + 2048 + h * 256; }
            attn_unit<1>(F.lds, u, F.tid, F.wave, F.lane);
        }
    }
}

constexpr int NWAVES = 8;
#ifndef EN
#define EN 0xFFFF
#endif
constexpr int PH_PER_LAYER = 7, N_PHASES = 1 + 4 * PH_PER_LAYER;
#ifndef PG8_SP2
#define PG8_SP2 true
#endif
#ifndef PG8_ALIGN
#define PG8_ALIGN true
#endif

__global__ void __launch_bounds__(NWAVES * 64, 2) fwd_kernel(Args args) {
    extern __shared__ __attribute__((aligned(16))) unsigned char lds_raw[];
#define MAKE_FRAME() Frame F; { int t_ = threadIdx.x; asm volatile("" : "+v"(t_)); F.lds = (LAS unsigned char*)lds_raw; F.tid = t_; F.lane = t_ & 63; F.wave = __builtin_amdgcn_readfirstlane(t_ >> 6); \
        F.G = gridDim.x; F.gw = blockIdx.x * NWAVES + F.wave; F.ngw = F.G * NWAVES; F.gtid = (long)blockIdx.x * (NWAVES * 64) + t_; F.nthreads = (long)F.G * NWAVES * 64; }
    volatile LAS unsigned* MISC = (volatile LAS unsigned*)((LAS unsigned char*)lds_raw + LDS_MISC);
    LAS unsigned long long* ptab = (LAS unsigned long long*)((LAS unsigned char*)lds_raw + LDS_MISC + 128);
    if (threadIdx.x < 32) MISC[threadIdx.x] = 0u;
    if (threadIdx.x < N_INPUTS) ptab[threadIdx.x] = (unsigned long long)args.in[threadIdx.x];
    if (threadIdx.x == 64) { ptab[N_INPUTS] = (unsigned long long)args.out; ptab[N_INPUTS + 1] = (unsigned long long)args.ws; }
    __syncthreads();
#define LOAD_ARGS() Args a; { asm volatile("" ::: "memory"); _Pragma("unroll") for (int k_ = 0; k_ < N_INPUTS; ++k_) a.in[k_] = (const float*)(const GAS float*)ldptr(ptab, k_); \
        a.out = (float*)(GAS float*)ldptr(ptab, N_INPUTS); a.ws = (unsigned char*)(GAS unsigned char*)ldptr(ptab, N_INPUTS + 1); a.ph_lo = 0; a.ph_hi = 0; } unsigned char* const ws = a.ws; \
        const pg8::bf16_t* XB = (const pg8::bf16_t*)(ws + WS_XB); float* ssa = (float*)(ws + WS_SSA); float* ssb = (float*)(ws + WS_SSB); (void)XB; (void)ssa; (void)ssb
#if MK_N_LAUNCHES == 1
    constexpr int lo = 0, hi = N_PHASES;
#else
    const int lo = args.ph_lo, hi = args.ph_hi;
#endif
    XcdBarrier bar; bar.bar = (unsigned*)(args.ws + WS_CTL) + CW_BAR; bar.x = 0; bar.st = nullptr;
    if (hi - lo > 1) bar = xcd_barrier_post((unsigned*)(args.ws + WS_CTL) + CW_BAR, MISC + 8);
#define IN(k) (lo <= (k) && (k) < hi)
#define SEAM(k) do { if (IN(k) && IN((k) + 1)) { asm volatile("" ::: "memory"); XcdBarrier b2_; b2_.bar = (unsigned*)((unsigned char*)(GAS unsigned char*)ldptr(ptab, N_INPUTS + 1) + WS_CTL) + CW_BAR; b2_.x = bar.x; b2_.st = bar.st; xcd_barrier(b2_); } } while (0)
    PG8_LAS unsigned char* glds = (PG8_LAS unsigned char*)lds_raw;
    PG8_LAS float* exch = (PG8_LAS float*)(lds_raw + LDS_EXCH);

    if (IN(0) && (EN & 1)) { MAKE_FRAME(); LOAD_ARGS(); p0_prologue(a, F); }
#if defined(PROBE_REPEAT)
    if (PROBE_REPEAT & 4) { SEAM(0); MAKE_FRAME(); LOAD_ARGS(); p0_prologue(a, F); }
#endif
    SEAM(0);

    for (int i = 0; i < 4; ++i) {
        const int pb = 1 + i * PH_PER_LAYER, j = i >> 1; const bool att = (i & 1) != 0;
        if (IN(pb) && (EN & 2)) {
            LOAD_ARGS();
            if (!att) {
                pg8::Gemm g{XB, (const pg8::bf16_t*)(ws + WS_WINL + j * SZ_WINL), M, N_IN_LRU, D}; pg8::StaticOrder S; S.init(M, N_IN_LRU, (int)gridDim.x, (int)blockIdx.x);
                pg8::EpiLruIn E{ssa, (bf16_t*)(ws + WS_Z0), (bf16_t*)(ws + WS_Z1), (bf16_t*)(ws + WS_MQ), a.out, a.in[I_MQN] + i * 256, exch, j};
                pg8::gemm_phase<pg8::EpiLruIn, pg8::StaticOrder, PG8_ALIGN, PG8_SP2>(glds, g, S, E);
                if (i == 0) {
                    pg8::Gemm g2{(const pg8::bf16_t*)(ws + WS_MEMB), (const pg8::bf16_t*)(ws + WS_WKV), 512, 8192, D}; pg8::StaticOrder S2; S2.init(512, 8192, (int)gridDim.x, (int)blockIdx.x);
                    pg8::EpiMemKV E2{(const float*)(ws + WS_MEMRS), a.in[I_MKN], (bf16_t*)(ws + WS_MEMK), (bf16_t*)(ws + WS_MEMV), a.out, exch};
                    pg8::gemm_phase<pg8::EpiMemKV, pg8::StaticOrder, PG8_ALIGN, PG8_SP2>(glds, g2, S2, E2);
                }
            } else {
                pg8::Gemm g{XB, (const pg8::bf16_t*)(ws + WS_WINA + j * SZ_WINA), M, N_IN_ATT, D}; pg8::StaticOrder S; S.init(M, N_IN_ATT, (int)gridDim.x, (int)blockIdx.x);
                pg8::EpiAttIn E{ssa, (bf16_t*)(ws + WS_Z0), (bf16_t*)(ws + WS_Z1), (bf16_t*)(ws + WS_Z2), (bf16_t*)(ws + WS_MQ), a.out,
                                a.in[I_AQN] + j * 128, a.in[I_AKN] + j * 128, a.in[I_MQN] + i * 256, exch, j};
                pg8::gemm_phase<pg8::EpiAttIn, pg8::StaticOrder, PG8_ALIGN, PG8_SP2>(glds, g, S, E);
            }
        }
        SEAM(pb);
        if (IN(pb + 1) && (EN & 4)) { MAKE_FRAME(); LOAD_ARGS(); if (att) { if (EN & 64) mixer_phase<true>(a, F, i, i); } else { if (EN & 128) mixer_phase<false>(a, F, i, i); } }
#if defined(PROBE_REPEAT)
        if ((PROBE_REPEAT & 1) && att) { SEAM(pb); MAKE_FRAME(); LOAD_ARGS(); mixer_phase<true>(a, F, i, 4 + i); }
        if ((PROBE_REPEAT & 2) && !att) { SEAM(pb); MAKE_FRAME(); LOAD_ARGS(); mixer_phase<false>(a, F, i, 4 + i); }
#endif
        SEAM(pb + 1);
        if (IN(pb + 2) && (EN & 8)) { MAKE_FRAME(); LOAD_ARGS(); if (!att) lru_b_phase(a, F, j); }
        if (!att) SEAM(pb + 2);
        if (IN(pb + 3) && (EN & 16)) {
            LOAD_ARGS();
            pg8::Gemm g{(const pg8::bf16_t*)(ws + WS_AOUT), (const pg8::bf16_t*)(ws + WS_WOUT + i * SZ_WOUT), M, D, K_OUT}; pg8::StaticOrder S; S.init(M, D, (int)gridDim.x, (int)blockIdx.x);
            const float* b0 = (i == 0) ? a.in[I_XP] : a.out + O_Y; const float* b1 = (i == 0) ? a.in[I_XS] : a.out + O_Y + (size_t)MP * D;
            pg8::EpiResid E{b0, b1, a.out + O_Y, (bf16_t*)(ws + WS_XB), ssb, exch};
            pg8::gemm_phase<pg8::EpiResid, pg8::StaticOrder, PG8_ALIGN, PG8_SP2>(glds, g, S, E);
        }
        SEAM(pb + 3);
        if (IN(pb + 4) && (EN & 32)) {
            LOAD_ARGS();
            pg8::Gemm g{XB, (const pg8::bf16_t*)(ws + WS_WUP + i * SZ_WUP), M, N_UP, D}; pg8::StaticOrder S; S.init(M, N_UP, (int)gridDim.x, (int)blockIdx.x);
            pg8::EpiUp E{ssb, (bf16_t*)(ws + WS_UP), a.out, exch, i};
            pg8::gemm_phase<pg8::EpiUp, pg8::StaticOrder, PG8_ALIGN, PG8_SP2>(glds, g, S, E);
        }
        SEAM(pb + 4);
        if (IN(pb + 5) && (EN & 256)) { MAKE_FRAME(); LOAD_ARGS(); ffn_act_phase(a, F, i); }
        SEAM(pb + 5);
        if (IN(pb + 6) && (EN & 512)) {
            LOAD_ARGS();
            pg8::Gemm g{(const pg8::bf16_t*)(ws + WS_ACT), (const pg8::bf16_t*)(ws + WS_WDN + i * SZ_WDN), M, D, DFF}; pg8::StaticOrder S; S.init(M, D, (int)gridDim.x, (int)blockIdx.x);
            pg8::EpiResid E{a.out + O_Y, a.out + O_Y + (size_t)MP * D, a.out + O_Y, (bf16_t*)(ws + WS_XB), ssa, exch};
            pg8::gemm_phase<pg8::EpiResid, pg8::StaticOrder, PG8_ALIGN, PG8_SP2>(glds, g, S, E);
        }
        if (i < 3) SEAM(pb + 6);
    }
#undef IN
#undef SEAM
}

extern "C" void kernel_launch(void* const* d_in, const int* in_sizes, int n_in, void* d_out, int out_size, void* d_ws, size_t ws_size, hipStream_t stream) {
    static int grid = 0;
    if (grid == 0) {
        if (n_in != N_INPUTS || (size_t)out_size != O_END || ws_size < WS_END) { fprintf(stderr, "kernel_launch: unexpected shapes (n_in %d, out %d, ws %zu; need %d, %zu, >= %zu); nothing launched\n", n_in, out_size, ws_size, (int)N_INPUTS, (size_t)O_END, (size_t)WS_END); grid = -1; return; }
        int dev = 0, cus = 0, per_cu = 0;
        if (hipGetDevice(&dev) != hipSuccess || hipDeviceGetAttribute(&cus, hipDeviceAttributeMultiprocessorCount, dev) != hipSuccess) { grid = -1; return; }
        if (hipFuncSetAttribute((const void*)fwd_kernel, hipFuncAttributeMaxDynamicSharedMemorySize, LDS_BYTES) != hipSuccess) { fprintf(stderr, "kernel_launch: hipFuncSetAttribute failed\n"); grid = -1; return; }
        if (hipOccupancyMaxActiveBlocksPerMultiprocessor(&per_cu, (const void*)fwd_kernel, NWAVES * 64, LDS_BYTES) != hipSuccess || per_cu < 1) { fprintf(stderr, "kernel_launch: occupancy query says %d blocks per CU\n", per_cu); }
        (void)hipGetLastError();
        grid = cus;
    }
    if (grid < 0) return;
    (void)hipMemsetAsync((char*)d_ws + WS_CTL, 0, CTL_BYTES, stream);
    Args a{};
    for (int i = 0; i < N_INPUTS; ++i) a.in[i] = (const float*)d_in[i];
    a.out = (float*)d_out; a.ws = (unsigned char*)d_ws;
#if MK_N_LAUNCHES == 1
    a.ph_lo = 0; a.ph_hi = N_PHASES;
    hipLaunchKernelGGL(fwd_kernel, dim3(grid), dim3(NWAVES * 64), LDS_BYTES, stream, a);
#else
    for (int p = 0; p < N_PHASES; ++p) {
        if (p >= 1 && ((p - 1) % PH_PER_LAYER) == 2 && (((p - 1) / PH_PER_LAYER) & 1)) continue;
        a.ph_lo = p; a.ph_hi = p + 1;
        hipLaunchKernelGGL(fwd_kernel, dim3(grid), dim3(NWAVES * 64), LDS_BYTES, stream, a);
    }
#endif
}
```
